# Optimizing an MI355X kernel written in HIP

```python
import jax, jax.numpy as jnp
from jax import lax
import numpy as np

D_MODEL = 1024
BATCH = 8
SEQ = 8192
DEPTH = 4
DEC_BATCH = 16
DEC_SEQ = 2048
PAST_LEN = 128

N_MIXERS = 2
N_A_LAYERS = (DEPTH + 1) // 2
N_B_LAYERS = DEPTH // 2
PLE_DIM = 256
RMS_EPS = 1e-6
ROPE_THETA = 500000.0
BLOCK = 128
NEG_INF = -1e30
A_HEADS = 16
A_KV_HEADS = 4
A_GROUP = A_HEADS // A_KV_HEADS
A_HEAD_DIM = 64
A_ROT_DIM = A_HEAD_DIM // 4
WINDOW = 128
A_QKV_DIM = (A_HEADS + 2 * A_KV_HEADS) * A_HEAD_DIM
B_HEADS = 16
B_Q_RANK = 384
B_KV_RANK = 128
B_NOPE_DIM = 64
B_ROPE_DIM = 32
B_V_DIM = 64
B_QK_DIM = B_NOPE_DIM + B_ROPE_DIM
B_IN_DIM = B_Q_RANK + B_KV_RANK + B_ROPE_DIM
FFN_HIDDEN = ((8 * D_MODEL + 3 * 256 - 1) // (3 * 256)) * 256

kernel_name = "hybrid_swa_sink_mla_encoder"


def rmsnorm(x, g):
    xf = x.astype(jnp.float32)
    y = xf * lax.rsqrt(jnp.mean(xf * xf, axis=-1, keepdims=True) + RMS_EPS)
    return (y * g.astype(jnp.float32)).astype(x.dtype)


def rope_tables(seq, rot_dim, dtype):
    inv = 1.0 / (ROPE_THETA ** (jnp.arange(0, rot_dim, 2, dtype=jnp.float32) / rot_dim))
    ang = jnp.arange(seq, dtype=jnp.float32)[:, None] * inv[None, :]
    return jnp.cos(ang).astype(dtype), jnp.sin(ang).astype(dtype)


def apply_rope(x, cos, sin):
    half = x.shape[-1] // 2
    x1, x2 = x[..., :half], x[..., half:]
    c = cos[:, None, :]
    s = sin[:, None, :]
    return jnp.concatenate([x1 * c - x2 * s, x1 * s + x2 * c], axis=-1)


def windowed_gqa(h, w_qkv, q_gain, k_gain, sink, w_o):
    B, S, _ = h.shape
    nb = S // BLOCK
    qkv = h @ w_qkv
    q = qkv[..., :A_HEADS * A_HEAD_DIM].reshape(B, S, A_HEADS, A_HEAD_DIM)
    k = qkv[..., A_HEADS * A_HEAD_DIM:(A_HEADS + A_KV_HEADS) * A_HEAD_DIM].reshape(B, S, A_KV_HEADS, A_HEAD_DIM)
    v = qkv[..., (A_HEADS + A_KV_HEADS) * A_HEAD_DIM:].reshape(B, S, A_KV_HEADS, A_HEAD_DIM)
    q = rmsnorm(q, q_gain)
    k = rmsnorm(k, k_gain)
    cos, sin = rope_tables(S, A_ROT_DIM, h.dtype)
    q = jnp.concatenate([apply_rope(q[..., :A_ROT_DIM], cos, sin), q[..., A_ROT_DIM:]], axis=-1)
    k = jnp.concatenate([apply_rope(k[..., :A_ROT_DIM], cos, sin), k[..., A_ROT_DIM:]], axis=-1)

    qb = q.reshape(B, nb, BLOCK, A_KV_HEADS, A_GROUP, A_HEAD_DIM)
    pad = ((0, 0), (BLOCK, BLOCK), (0, 0), (0, 0))
    kp = jnp.pad(k, pad).reshape(B, nb + 2, BLOCK, A_KV_HEADS, A_HEAD_DIM)
    vp = jnp.pad(v, pad).reshape(B, nb + 2, BLOCK, A_KV_HEADS, A_HEAD_DIM)
    kn = jnp.concatenate([kp[:, :-2], kp[:, 1:-1], kp[:, 2:]], axis=2)
    vn = jnp.concatenate([vp[:, :-2], vp[:, 1:-1], vp[:, 2:]], axis=2)

    scale = A_HEAD_DIM ** -0.5
    scores = jnp.einsum('bnqkgd,bnjkd->bnkgqj', qb, kn).astype(jnp.float32) * scale
    qi = jnp.arange(BLOCK, dtype=jnp.int32)[:, None]
    kj = jnp.arange(3 * BLOCK, dtype=jnp.int32)[None, :]
    in_window = jnp.abs(kj - BLOCK - qi) <= WINDOW
    key_pos = (jnp.arange(nb, dtype=jnp.int32)[:, None] - 1) * BLOCK + kj
    in_range = (key_pos >= 0) & (key_pos < S)
    mask = in_window[None, :, :] & in_range[:, None, :]
    scores = jnp.where(mask[None, :, None, None, :, :], scores, NEG_INF)

    sink_b = sink.astype(jnp.float32).reshape(A_KV_HEADS, A_GROUP)[None, None, :, :, None, None]
    m = jnp.maximum(jnp.max(scores, axis=-1, keepdims=True), sink_b)
    e = jnp.exp(scores - m)
    denom = jnp.sum(e, axis=-1, keepdims=True) + jnp.exp(sink_b - m)
    probs = (e / denom).astype(v.dtype)
    out = jnp.einsum('bnkgqj,bnjkd->bnqkgd', probs, vn)
    return out.reshape(B, S, A_HEADS * A_HEAD_DIM) @ w_o


def mla(h, w_in, q_lat_gain, kv_lat_gain, w_uq, w_ukv, q_gain, k_gain, w_o):
    B, S, _ = h.shape
    nb = S // BLOCK
    lat = h @ w_in
    cq = rmsnorm(lat[..., :B_Q_RANK], q_lat_gain)
    ckv = rmsnorm(lat[..., B_Q_RANK:B_Q_RANK + B_KV_RANK], kv_lat_gain)
    k_rope = lat[..., B_Q_RANK + B_KV_RANK:]
    q = (cq @ w_uq).reshape(B, S, B_HEADS, B_QK_DIM)
    kv = (ckv @ w_ukv).reshape(B, S, B_HEADS, B_NOPE_DIM + B_V_DIM)
    k_nope, v = kv[..., :B_NOPE_DIM], kv[..., B_NOPE_DIM:]
    k_r = jnp.broadcast_to(k_rope[:, :, None, :], (B, S, B_HEADS, B_ROPE_DIM))
    k = jnp.concatenate([k_nope, k_r], axis=-1)
    q = rmsnorm(q, q_gain)
    k = rmsnorm(k, k_gain)
    cos, sin = rope_tables(S, B_ROPE_DIM, h.dtype)
    q = jnp.concatenate([q[..., :B_NOPE_DIM], apply_rope(q[..., B_NOPE_DIM:], cos, sin)], axis=-1)
    k = jnp.concatenate([k[..., :B_NOPE_DIM], apply_rope(k[..., B_NOPE_DIM:], cos, sin)], axis=-1)

    scale = B_QK_DIM ** -0.5
    qb = q.reshape(B, nb, BLOCK, B_HEADS, B_QK_DIM).transpose(1, 0, 2, 3, 4)

    def attend(qblk):
        s = jnp.einsum('bqhd,bkhd->bhqk', qblk, k).astype(jnp.float32) * scale
        p = jax.nn.softmax(s, axis=-1).astype(v.dtype)
        return jnp.einsum('bhqk,bkhd->bqhd', p, v)

    o = lax.map(attend, qb)
    o = o.transpose(1, 0, 2, 3, 4).reshape(B, S, B_HEADS * B_V_DIM)
    return o @ w_o


def swiglu(h, w_gate_up, w_down):
    gu = h @ w_gate_up
    return (jax.nn.silu(gu[..., :FFN_HIDDEN]) * gu[..., FFN_HIDDEN:]) @ w_down


def trunk(x, p, mix_norm, a_w_qkv, a_q_norm, a_k_norm, a_sink, a_w_o,
          b_w_in, b_q_lat_norm, b_kv_lat_norm, b_w_uq, b_w_ukv, b_q_norm, b_k_norm, b_w_o,
          ffn_norm, ffn_w_gate_up, ffn_w_down, ple_norm, ple_w_gate, ple_w_proj):
    for i in range(DEPTH):
        j = i // N_MIXERS
        h = rmsnorm(x, mix_norm[i])
        if i % N_MIXERS == 0:
            x = x + windowed_gqa(h, a_w_qkv[j], a_q_norm[j], a_k_norm[j], a_sink[j], a_w_o[j])
        else:
            x = x + mla(h, b_w_in[j], b_q_lat_norm[j], b_kv_lat_norm[j], b_w_uq[j], b_w_ukv[j],
                        b_q_norm[j], b_k_norm[j], b_w_o[j])
        x = x + swiglu(rmsnorm(x, ffn_norm[i]), ffn_w_gate_up[i], ffn_w_down[i])
        gate = jax.nn.sigmoid(rmsnorm(x, ple_norm[i]) @ ple_w_gate[i])
        x = x + gate * (p[i] @ ple_w_proj[i])
    return x


def setup_inputs(seed: int = 0) -> dict:
    key = jax.random.key(seed)
    ks = jax.random.split(key, 32)
    f32 = jnp.float32

    def w(k, shape, fan_in):
        return jax.random.normal(k, shape, f32) * (fan_in ** -0.5)

    def gain(k, shape):
        return 1.0 + 0.02 * jax.random.normal(k, shape, f32)

    return {
        "x_prompt": jax.random.normal(ks[0], (BATCH, SEQ, D_MODEL), f32),
        "x_sample": jax.random.normal(ks[1], (DEC_BATCH, DEC_SEQ, D_MODEL), f32),
        "p_prompt": jax.random.normal(ks[2], (DEPTH, BATCH, SEQ, PLE_DIM), f32),
        "p_sample": jax.random.normal(ks[3], (DEPTH, DEC_BATCH, DEC_SEQ, PLE_DIM), f32),
        "mix_norm": gain(ks[4], (DEPTH, D_MODEL)),
        "a_w_qkv": w(ks[5], (N_A_LAYERS, D_MODEL, A_QKV_DIM), D_MODEL),
        "a_q_norm": gain(ks[6], (N_A_LAYERS, A_HEAD_DIM)),
        "a_k_norm": gain(ks[7], (N_A_LAYERS, A_HEAD_DIM)),
        "a_sink": 0.5 * jax.random.normal(ks[8], (N_A_LAYERS, A_HEADS), f32),
        "a_w_o": w(ks[9], (N_A_LAYERS, A_HEADS * A_HEAD_DIM, D_MODEL), A_HEADS * A_HEAD_DIM),
        "b_w_in": w(ks[10], (N_B_LAYERS, D_MODEL, B_IN_DIM), D_MODEL),
        "b_q_lat_norm": gain(ks[11], (N_B_LAYERS, B_Q_RANK)),
        "b_kv_lat_norm": gain(ks[12], (N_B_LAYERS, B_KV_RANK)),
        "b_w_uq": w(ks[13], (N_B_LAYERS, B_Q_RANK, B_HEADS * B_QK_DIM), B_Q_RANK),
        "b_w_ukv": w(ks[14], (N_B_LAYERS, B_KV_RANK, B_HEADS * (B_NOPE_DIM + B_V_DIM)), B_KV_RANK),
        "b_q_norm": gain(ks[15], (N_B_LAYERS, B_QK_DIM)),
        "b_k_norm": gain(ks[16], (N_B_LAYERS, B_QK_DIM)),
        "b_w_o": w(ks[17], (N_B_LAYERS, B_HEADS * B_V_DIM, D_MODEL), B_HEADS * B_V_DIM),
        "ffn_norm": gain(ks[18], (DEPTH, D_MODEL)),
        "ffn_w_gate_up": w(ks[19], (DEPTH, D_MODEL, 2 * FFN_HIDDEN), D_MODEL),
        "ffn_w_down": w(ks[20], (DEPTH, FFN_HIDDEN, D_MODEL), FFN_HIDDEN),
        "ple_norm": gain(ks[21], (DEPTH, D_MODEL)),
        "ple_w_gate": w(ks[22], (DEPTH, D_MODEL, D_MODEL), D_MODEL),
        "ple_w_proj": w(ks[23], (DEPTH, PLE_DIM, D_MODEL), PLE_DIM),
    }


def reference(x_prompt, x_sample, p_prompt, p_sample, mix_norm, a_w_qkv, a_q_norm, a_k_norm,
              a_sink, a_w_o, b_w_in, b_q_lat_norm, b_kv_lat_norm, b_w_uq, b_w_ukv, b_q_norm,
              b_k_norm, b_w_o, ffn_norm, ffn_w_gate_up, ffn_w_down, ple_norm, ple_w_gate,
              ple_w_proj):
    y_prompt = trunk(x_prompt, p_prompt, mix_norm, a_w_qkv, a_q_norm, a_k_norm, a_sink, a_w_o,
                     b_w_in, b_q_lat_norm, b_kv_lat_norm, b_w_uq, b_w_ukv, b_q_norm, b_k_norm, b_w_o,
                     ffn_norm, ffn_w_gate_up, ffn_w_down, ple_norm, ple_w_gate, ple_w_proj)
    y_sample = trunk(x_sample, p_sample, mix_norm, a_w_qkv, a_q_norm, a_k_norm, a_sink, a_w_o,
                     b_w_in, b_q_lat_norm, b_kv_lat_norm, b_w_uq, b_w_ukv, b_q_norm, b_k_norm, b_w_o,
                     ffn_norm, ffn_w_gate_up, ffn_w_down, ple_norm, ple_w_gate, ple_w_proj)
    return (y_prompt, y_sample)
```

```cpp
#include <hip/hip_runtime.h>
#include <hip/hip_cooperative_groups.h>
#include <cstdio>
#include <cstdint>
namespace cg = cooperative_groups;

constexpr int TT = 98304;
constexpr int TH = 49152;
constexpr int DM = 1024, FFH = 2816, PLE = 256;
constexpr float EPS = 1e-6f;
constexpr float LOG2E = 1.4426950408889634f;

__device__ __forceinline__ int ext_row(int r) { const int h = r >= TH ? 1 : 0; const int o = r - h * TH; return o < 32768 ? h * 32768 + o : 65536 + h * 16384 + (o - 32768); }
__device__ __forceinline__ void seq_of(int tok, int& st, int& S) { const int h = tok >= TH ? 1 : 0; const int o = tok - h * TH;
    if (o < 32768) { S = 8192; st = h * TH + (o & ~8191); } else { S = 2048; st = h * TH + 32768 + ((o - 32768) & ~2047); } }

namespace pg8 {
#define PG8_LAS __attribute__((address_space(3)))
typedef unsigned short bf16_t;
typedef short bf16x8 __attribute__((ext_vector_type(8)));
typedef float f32x4 __attribute__((ext_vector_type(4)));
typedef unsigned u32x4 __attribute__((ext_vector_type(4)));
constexpr int BM = 256, BK = 64, HALF = 128, HTB = HALF * BK * 2  , STAGE_BYTES = 8 * HTB, NXCD = 8, WGM = 8;

__host__ __device__ __forceinline__ int lds_byte(int r, int c) { const int st = (r >> 4) * 2 + (c >> 5), rr = r & 15, cc = c & 31, ob = rr * 64 + cc * 2; return st * 1024 + (ob ^ (((ob >> 9) & 1) << 5)); }
__host__ __device__ __forceinline__ void stage_rc(int b, int& R, int& C) { const int st = b / 1024, sb = b % 1024, swz = sb ^ (((sb >> 9) & 1) << 5); R = (st >> 1) * 16 + swz / 64; C = (st & 1) * 32 + (swz % 64) / 2; }
__host__ __device__ __forceinline__ int perm32(int rho) { const int n = rho >> 4, i = rho & 15; return 8 * (i >> 2) + 4 * n + (i & 3); }

struct Unit { int pm, pn; };
struct Gemm { const bf16_t* A; const bf16_t* Bt; int M, N, K, lda, ldb; };

struct StaticOrder {
    int nM, nN, nwg, G, c;
    __host__ __device__ void init(int M, int N, int G_, int c_) { nM = M / BM; nN = N / BM; nwg = nM * nN; G = G_; c = c_; }
    __host__ __device__ bool next(int i, Unit& u) const {
        const long L = (long)i * G + c; if (L >= nwg) return false;
        int wgid = (int)L; { const int q = nwg / NXCD, r = nwg % NXCD, xcd = wgid % NXCD, off = wgid / NXCD; wgid = (xcd < r ? xcd * (q + 1) : r * (q + 1) + (xcd - r) * q) + off; }
        const int nig = WGM * nN, gid = wgid / nig, fm = gid * WGM, gsz = (nM - fm) < WGM ? (nM - fm) : WGM;
        u.pm = fm + ((wgid % nig) % gsz); u.pn = (wgid % nig) / gsz; return true;
    }
    __device__ __forceinline__ void a_ready(const Unit&) const {}
    __device__ __forceinline__ void done(const Unit&) const {}
};

__device__ __forceinline__ unsigned cvt_pk_bf16(float lo, float hi) { unsigned r; asm volatile("v_cvt_pk_bf16_f32 %0, %1, %2" : "=v"(r) : "v"(lo), "v"(hi)); return r; }
typedef unsigned u32x2 __attribute__((ext_vector_type(2)));
__device__ __forceinline__ float bf_lo(unsigned w) { return __uint_as_float(w << 16); }
__device__ __forceinline__ float bf_hi(unsigned w) { return __uint_as_float(w & 0xffff0000u); }

struct RowScale { const float* ss; int s0, ns4; float inv_dim;
    __device__ __forceinline__ float get(int row) const {
        if (!ss) return 1.f;
        const f32x4* p = (const f32x4*)(ss + (size_t)row * 16 + s0); float s = 0.f;
        for (int i = 0; i < ns4; ++i) { const f32x4 v = p[i]; s += (v[0] + v[1]) + (v[2] + v[3]); }
        return __builtin_amdgcn_rsqf(s * inv_dim + EPS);
    } };

struct EpiScale {
    static constexpr bool PERM = true, AFTER_DRAIN = false;
    bf16_t* O; int ldc; RowScale rs;
    __device__ __forceinline__ void operator()(const f32x4 (&acc)[2][2][4][2], const Unit& u, int wr, int wc, int fr, int fq) const {
        const int row0 = u.pm * BM + wr * 64 + fr, col0 = u.pn * BM + wc * 32 + 8 * fq;
#pragma unroll
        for (int ai = 0; ai < 2; ++ai)
#pragma unroll
            for (int m = 0; m < 4; ++m) { const int row = row0 + ai * HALF + m * 16; const float s = rs.get(row); bf16_t* rp = O + (size_t)row * ldc + col0;
#pragma unroll
                for (int bj = 0; bj < 2; ++bj) { const f32x4 v0 = acc[ai][bj][m][0] * s, v1 = acc[ai][bj][m][1] * s; u32x4 w; w.x = cvt_pk_bf16(v0[0], v0[1]); w.y = cvt_pk_bf16(v0[2], v0[3]); w.z = cvt_pk_bf16(v1[0], v1[1]); w.w = cvt_pk_bf16(v1[2], v1[3]);
                    *(u32x4*)(rp + bj * HALF) = w; } }
    }
};

struct EpiLat {
    static constexpr bool PERM = false, AFTER_DRAIN = false;
    bf16_t* LQ; bf16_t* LKV; float* KR; float* SSL; RowScale rs;
    __device__ __forceinline__ void operator()(const f32x4 (&acc)[2][2][4][2], const Unit& u, int wr, int wc, int fr, int fq) const {
        const int row0 = u.pm * BM + wr * 64 + fr, col0 = u.pn * BM + wc * 32 + 4 * fq;
#pragma unroll
        for (int ai = 0; ai < 2; ++ai)
#pragma unroll
            for (int m = 0; m < 4; ++m) { const int row = row0 + ai * HALF + m * 16; const float s = rs.get(row); float q[2] = {0.f, 0.f};
#pragma unroll
                for (int bj = 0; bj < 2; ++bj)
#pragma unroll
                    for (int n = 0; n < 2; ++n) { const f32x4 v = acc[ai][bj][m][n] * s; q[bj] += (v[0] * v[0] + v[1] * v[1]) + (v[2] * v[2] + v[3] * v[3]);
                        const int col = col0 + bj * HALF + n * 16; u32x2 w; w.x = cvt_pk_bf16(v[0], v[1]); w.y = cvt_pk_bf16(v[2], v[3]);
                        if (col < 384) *(u32x2*)(LQ + (size_t)row * 384 + col) = w;
                        else if (col < 512) *(u32x2*)(LKV + (size_t)row * 128 + (col - 384)) = w;
                        else if (col < 544) *(f32x4*)(KR + (size_t)row * 32 + (col - 512)) = v; }
                float q0 = q[0], q1 = q[1];
                q0 += __shfl_xor(q0, 16); q0 += __shfl_xor(q0, 32); q1 += __shfl_xor(q1, 16); q1 += __shfl_xor(q1, 32);
                if (fq == 0) { if (u.pn == 0) SSL[(size_t)row * 16 + wc] = q0 + q1; else if (u.pn == 1) { SSL[(size_t)row * 16 + 4 + wc] = q0; SSL[(size_t)row * 16 + 8 + wc] = q1; } } }
    }
};

struct EpiSwiglu {
    static constexpr bool PERM = true, AFTER_DRAIN = false;
    bf16_t* H; RowScale rs;
    __device__ __forceinline__ void operator()(const f32x4 (&acc)[2][2][4][2], const Unit& u, int wr, int wc, int fr, int fq) const {
        const int row0 = u.pm * BM + wr * 64 + fr, col0 = u.pn * HALF + wc * 32 + 8 * fq;
#pragma unroll
        for (int ai = 0; ai < 2; ++ai)
#pragma unroll
            for (int m = 0; m < 4; ++m) { const int row = row0 + ai * HALF + m * 16; const float s = rs.get(row); bf16_t* rp = H + (size_t)row * FFH + col0; float h[8];
#pragma unroll
                for (int n = 0; n < 2; ++n) { const f32x4 g = acc[ai][0][m][n] * s, up = acc[ai][1][m][n] * s;
#pragma unroll
                    for (int j = 0; j < 4; ++j) h[4 * n + j] = g[j] * __builtin_amdgcn_rcpf(1.f + __builtin_amdgcn_exp2f(-g[j] * LOG2E)) * up[j]; }
                u32x4 w; w.x = cvt_pk_bf16(h[0], h[1]); w.y = cvt_pk_bf16(h[2], h[3]); w.z = cvt_pk_bf16(h[4], h[5]); w.w = cvt_pk_bf16(h[6], h[7]); *(u32x4*)rp = w; }
    }
};

template <bool PLEG> struct EpiResid {
    static constexpr bool PERM = false, AFTER_DRAIN = false;
    float* X; int row_int0; bf16_t* XBo; float* SSn; const bf16_t* PROJ; RowScale rs; float amul;
    __device__ __forceinline__ void operator()(const f32x4 (&acc)[2][2][4][2], const Unit& u, int wr, int wc, int fr, int fq) const {
        const int ext0 = ext_row(row_int0 + u.pm * BM); const int col0 = u.pn * BM + wc * 32 + 4 * fq;
#pragma unroll
        for (int ai = 0; ai < 2; ++ai)
#pragma unroll
            for (int m = 0; m < 4; ++m) { const int lrow = wr * 64 + fr + ai * HALF + m * 16, row = u.pm * BM + lrow; float* xp = X + (size_t)(ext0 + lrow) * DM + col0;
                const float s = PLEG ? rs.get(row) : 0.f; float q = 0.f;
#pragma unroll
                for (int bj = 0; bj < 2; ++bj)
#pragma unroll
                    for (int n = 0; n < 2; ++n) { const int off = bj * HALF + n * 16; const f32x4 xo = *(const f32x4*)(xp + off); const f32x4 a = acc[ai][bj][m][n]; f32x4 xn;
                        if (PLEG) { const u32x2 pw = *(const u32x2*)(PROJ + (size_t)row * DM + col0 + off); const float p[4] = {bf_lo(pw.x), bf_hi(pw.x), bf_lo(pw.y), bf_hi(pw.y)};
#pragma unroll
                            for (int j = 0; j < 4; ++j) xn[j] = xo[j] + __builtin_amdgcn_rcpf(1.f + __builtin_amdgcn_exp2f(-a[j] * s * LOG2E)) * p[j] * amul; }
                        else xn = xo + a * amul;
                        *(f32x4*)(xp + off) = xn; u32x2 w; w.x = cvt_pk_bf16(xn[0], xn[1]); w.y = cvt_pk_bf16(xn[2], xn[3]); *(u32x2*)(XBo + (size_t)row * DM + col0 + off) = w;
                        q += (xn[0] * xn[0] + xn[1] * xn[1]) + (xn[2] * xn[2] + xn[3] * xn[3]); }
                q += __shfl_xor(q, 16); q += __shfl_xor(q, 32);
                if (fq == 0) SSn[(size_t)row * 16 + u.pn * 4 + wc] = q; }
    }
};

template <class Epi, class Sched, bool ALIGN_EPI = false, bool SP2 = false>
__device__ __forceinline__ void gemm_phase(PG8_LAS unsigned char* lds, const Gemm g, const Sched& S, const Epi& E) {
    int tid_l = threadIdx.x; asm volatile("" : "+v"(tid_l));
    const int tid = tid_l, wid = __builtin_amdgcn_readfirstlane(tid >> 6), lane = tid & 63, wr = wid >> 2, wc = wid & 3, fr = lane & 15, fq = lane >> 4;
    const int K = g.K, nt = K / BK;
    unsigned voffA[2], voffB[2];
#pragma unroll
    for (int i = 0; i < 2; ++i) { int R, C; stage_rc(tid * 16 + i * 8192, R, C); const int Rb = Epi::PERM ? ((R & ~31) + perm32(R & 31)) : R;
        voffA[i] = (unsigned)(R * g.lda + C) * 2u; voffB[i] = (unsigned)(Rb * g.ldb + C) * 2u; }
    const size_t kstep = (size_t)(BK * 2);
    const size_t hstepA = (size_t)HALF * g.lda * 2, hstepB = (size_t)HALF * g.ldb * 2;
    const size_t tstepA = 2 * hstepA, tstepB = 2 * hstepB;
    const unsigned ldsw = (unsigned)wid * 1024u;
    const int aoff = lds_byte(wr * 64 + fr, fq * 8), boff = lds_byte(wc * 32 + fr, fq * 8);
#define PG8_SA(b, h) (((b) * 2 + (h)) * HTB)
#define PG8_SB(b, h) ((4 + (b) * 2 + (h)) * HTB)
#define PG8_STAGE(bufoff, gbase, voff) do { _Pragma("unroll") for (int _i = 0; _i < 2; ++_i) \
        __builtin_amdgcn_global_load_lds((const unsigned*)((const char*)(gbase) + (voff)[_i]), (PG8_LAS unsigned*)(lds + (bufoff) + ldsw + _i * 8192), 16, 0, 0); } while (0)
#define PG8_LDA(dst, b, h) do { _Pragma("unroll") for (int m = 0; m < 4; ++m) _Pragma("unroll") for (int k = 0; k < 2; ++k) dst[m][k] = *(const PG8_LAS bf16x8*)(lds + PG8_SA(b, h) + aoff + m * 2048 + k * 1024); } while (0)
#define PG8_LDB(dst, b, h) do { _Pragma("unroll") for (int n = 0; n < 2; ++n) _Pragma("unroll") for (int k = 0; k < 2; ++k) dst[n][k] = *(const PG8_LAS bf16x8*)(lds + PG8_SB(b, h) + boff + n * 2048 + k * 1024); } while (0)
#define PG8_MMA(ai, bj, At, Bt) do { __builtin_amdgcn_s_setprio(1); _Pragma("unroll") for (int m = 0; m < 4; ++m) _Pragma("unroll") for (int n = 0; n < 2; ++n) _Pragma("unroll") for (int k = 0; k < 2; ++k) \
        acc[ai][bj][m][n] = __builtin_amdgcn_mfma_f32_16x16x32_bf16(Bt[n][k], At[m][k], acc[ai][bj][m][n], 0, 0, 0); __builtin_amdgcn_s_setprio(0); } while (0)
#define PG8_WAIT_V(n) asm volatile("s_waitcnt vmcnt(" #n ")" ::: "memory")
#define PG8_WAIT_L(n) asm volatile("s_waitcnt lgkmcnt(" #n ")" ::: "memory")
#define PG8_BAR __builtin_amdgcn_s_barrier()
#define PG8_SCHED __builtin_amdgcn_sched_barrier(0)
    Unit cur, nxt; int ui = 0;
    if (!S.next(0, cur)) return;
    f32x4 acc[2][2][4][2];
#pragma unroll
    for (int a = 0; a < 2; ++a)
#pragma unroll
        for (int b = 0; b < 2; ++b)
#pragma unroll
            for (int m = 0; m < 4; ++m)
#pragma unroll
                for (int n = 0; n < 2; ++n) acc[a][b][m][n] = (f32x4){0.f, 0.f, 0.f, 0.f};
    bf16x8 At[4][2], B0[2][2], B1[2][2];
    const char* cA = (const char*)g.A + (size_t)cur.pm * tstepA; const char* cB = (const char*)g.Bt + (size_t)cur.pn * tstepB;
    S.a_ready(cur);
    if constexpr (SP2) {
        PG8_STAGE(PG8_SB(0, 0), cB, voffB); PG8_STAGE(PG8_SB(0, 1), cB + hstepB, voffB); PG8_STAGE(PG8_SA(0, 0), cA, voffA); PG8_STAGE(PG8_SA(0, 1), cA + hstepA, voffA);
        if (wr == 1) PG8_BAR;
        PG8_WAIT_V(2); PG8_BAR;
        PG8_STAGE(PG8_SB(1, 0), cB + kstep, voffB); PG8_STAGE(PG8_SA(1, 0), cA + kstep, voffA); PG8_STAGE(PG8_SB(1, 1), cB + hstepB + kstep, voffB);
        PG8_WAIT_V(6); PG8_BAR;
    } else {
        PG8_STAGE(PG8_SB(0, 0), cB, voffB); PG8_STAGE(PG8_SA(0, 0), cA, voffA); PG8_STAGE(PG8_SB(0, 1), cB + hstepB, voffB); PG8_STAGE(PG8_SA(0, 1), cA + hstepA, voffA);
        if (wr == 1) PG8_BAR;
        PG8_WAIT_V(4); PG8_BAR;
        PG8_STAGE(PG8_SB(1, 0), cB + kstep, voffB); PG8_STAGE(PG8_SA(1, 0), cA + kstep, voffA); PG8_STAGE(PG8_SB(1, 1), cB + hstepB + kstep, voffB);
        PG8_WAIT_V(6); PG8_BAR;
    }
    for (;;) {
        const bool has_next = S.next(ui + 1, nxt);
        const char* nA = has_next ? (const char*)g.A + (size_t)nxt.pm * tstepA : cA; const char* nB = has_next ? (const char*)g.Bt + (size_t)nxt.pn * tstepB : cB;
        for (int t = 0; t < nt; t += 2) {
            const bool last = (t == nt - 2);
            const char* a1 = cA + (size_t)(t + 1) * kstep;
            const char* a2 = last ? nA : cA + (size_t)(t + 2) * kstep; const char* b2 = last ? nB : cB + (size_t)(t + 2) * kstep;
            const char* a3 = a2 + kstep; const char* b3 = b2 + kstep;
            if (last && has_next) S.a_ready(nxt);
            if constexpr (SP2) {
            PG8_LDB(B0, 0, 0); PG8_LDB(B1, 0, 1); PG8_SCHED; PG8_LDA(At, 0, 0); PG8_STAGE(PG8_SA(1, 1), a1 + hstepA, voffA);
            PG8_WAIT_V(8); PG8_WAIT_L(0); PG8_BAR; PG8_MMA(0, 0, At, B0); PG8_MMA(0, 1, At, B1); PG8_BAR; PG8_SCHED;
            PG8_LDA(At, 0, 1); PG8_STAGE(PG8_SB(0, 0), b2, voffB); PG8_STAGE(PG8_SB(0, 1), b2 + hstepB, voffB); PG8_STAGE(PG8_SA(0, 0), a2, voffA);
            PG8_WAIT_V(8); PG8_WAIT_L(0); PG8_BAR; PG8_MMA(1, 0, At, B0); PG8_MMA(1, 1, At, B1); PG8_BAR; PG8_SCHED;
            PG8_LDB(B0, 1, 0); PG8_LDB(B1, 1, 1); PG8_SCHED; PG8_LDA(At, 1, 0); PG8_STAGE(PG8_SA(0, 1), a2 + hstepA, voffA);
            PG8_WAIT_V(8); PG8_WAIT_L(0); PG8_BAR; PG8_MMA(0, 0, At, B0); PG8_MMA(0, 1, At, B1); PG8_BAR; PG8_SCHED;
            PG8_LDA(At, 1, 1); PG8_STAGE(PG8_SB(1, 0), b3, voffB); PG8_STAGE(PG8_SB(1, 1), b3 + hstepB, voffB); PG8_STAGE(PG8_SA(1, 0), a3, voffA);
            PG8_WAIT_V(8); PG8_WAIT_L(0); PG8_BAR; PG8_MMA(1, 0, At, B0); PG8_MMA(1, 1, At, B1); PG8_BAR; PG8_SCHED;
            } else {
            PG8_LDB(B0, 0, 0); PG8_SCHED; PG8_LDA(At, 0, 0); PG8_STAGE(PG8_SA(1, 1), a1 + hstepA, voffA);
            PG8_WAIT_L(8); PG8_BAR; PG8_WAIT_L(0); PG8_MMA(0, 0, At, B0); PG8_BAR; PG8_SCHED;
            PG8_LDB(B1, 0, 1); PG8_STAGE(PG8_SB(0, 0), b2, voffB);
            PG8_BAR; PG8_WAIT_L(0); PG8_MMA(0, 1, At, B1); PG8_BAR;
            PG8_LDA(At, 0, 1); PG8_STAGE(PG8_SA(0, 0), a2, voffA);
            PG8_BAR; PG8_WAIT_L(0); PG8_MMA(1, 0, At, B0); PG8_BAR; PG8_SCHED;
            PG8_STAGE(PG8_SB(0, 1), b2 + hstepB, voffB);
            PG8_WAIT_V(6); PG8_BAR; PG8_MMA(1, 1, At, B1); PG8_BAR;
            PG8_LDB(B0, 1, 0); PG8_SCHED; PG8_LDA(At, 1, 0); PG8_STAGE(PG8_SA(0, 1), a2 + hstepA, voffA);
            PG8_WAIT_L(8); PG8_BAR; PG8_WAIT_L(0); PG8_MMA(0, 0, At, B0); PG8_BAR; PG8_SCHED;
            PG8_LDB(B1, 1, 1); PG8_STAGE(PG8_SB(1, 0), b3, voffB);
            PG8_BAR; PG8_WAIT_L(0); PG8_MMA(0, 1, At, B1); PG8_BAR;
            PG8_LDA(At, 1, 1); PG8_STAGE(PG8_SA(1, 0), a3, voffA);
            PG8_BAR; PG8_WAIT_L(0); PG8_MMA(1, 0, At, B0); PG8_BAR; PG8_SCHED;
            PG8_STAGE(PG8_SB(1, 1), b3 + hstepB, voffB);
            PG8_WAIT_V(6); PG8_BAR; PG8_MMA(1, 1, At, B1); PG8_BAR;
            }
        }
        if constexpr (ALIGN_EPI) { if (wr == 0) PG8_BAR; }
        if constexpr (!Epi::AFTER_DRAIN) { E(acc, cur, wr, wc, fr, fq); S.done(cur); }
        if (!has_next) break;
#pragma unroll
        for (int a = 0; a < 2; ++a)
#pragma unroll
            for (int b = 0; b < 2; ++b)
#pragma unroll
                for (int m = 0; m < 4; ++m)
#pragma unroll
                    for (int n = 0; n < 2; ++n) acc[a][b][m][n] = (f32x4){0.f, 0.f, 0.f, 0.f};
        cur = nxt; cA = nA; cB = nB; ++ui;
        if constexpr (ALIGN_EPI) { if (wr == 1) PG8_BAR; }
    }
    PG8_WAIT_V(0);
    if constexpr (!ALIGN_EPI) { if (wr == 0) PG8_BAR; }
    PG8_BAR;
    if constexpr (Epi::AFTER_DRAIN) { E.fused(acc, cur, wr, wc, fr, fq, lds, wid, lane); S.done(cur); }
#undef PG8_SA
#undef PG8_SB
#undef PG8_STAGE
#undef PG8_LDA
#undef PG8_LDB
#undef PG8_MMA
#undef PG8_WAIT_V
#undef PG8_WAIT_L
#undef PG8_BAR
#undef PG8_SCHED
}
}

#define LAS __attribute__((address_space(3)))
typedef unsigned short bf16_t;
using pg8::bf16x8; using pg8::f32x4; using pg8::u32x4; using pg8::u32x2; using pg8::cvt_pk_bf16; using pg8::bf_lo; using pg8::bf_hi;
typedef float f32x16 __attribute__((ext_vector_type(16)));
typedef float f32x2 __attribute__((ext_vector_type(2)));

#define XB_TMO      128
#define XB_XCNT(j)  (256  + 64 * (j))
#define XB_XSUB(j)  (1280 + 64 * (j))
#define XB_XGEN(j)  (2304 + 64 * (j))
#define XB_TOP      3328
#define XB_TOPGEN   3392
#define XCD_BAR_WORDS 3456
#define XB_SPIN_CAP (1u << 18)

__device__ __forceinline__ unsigned xb_ld(unsigned* p)              { return __hip_atomic_load(p, __ATOMIC_RELAXED, __HIP_MEMORY_SCOPE_AGENT); }
__device__ __forceinline__ unsigned xb_add(unsigned* p, unsigned v) { return __hip_atomic_fetch_add(p, v, __ATOMIC_RELAXED, __HIP_MEMORY_SCOPE_AGENT); }
__device__ __forceinline__ unsigned xb_xcc_id() { return (unsigned)__builtin_amdgcn_s_getreg((3 << 11) | 20) & 0xFu; }
#define XB_SPIN(cond, bar) do { unsigned _sp = 0; while (cond) { __builtin_amdgcn_s_sleep(1); \
    if ((++_sp & 255u) == 0u) { if (xb_ld(&(bar)[XB_TMO])) break; if (_sp > XB_SPIN_CAP) { atomicAdd(&(bar)[XB_TMO], 1u); break; } } } } while (0)

struct XcdBarrier {
    unsigned* bar; unsigned x;
    volatile LAS unsigned* st;
};

__device__ __forceinline__ XcdBarrier xcd_barrier_post(unsigned* bar, volatile LAS unsigned* st) {
    XcdBarrier b; b.bar = bar; b.x = xb_xcc_id(); b.st = st;
    if (threadIdx.x == 0) (void)xb_add(&bar[XB_XCNT(b.x)], 1u);
    return b;
}
__device__ __forceinline__ void xcd_barrier_complete(unsigned* bar, unsigned x, unsigned& nloc, unsigned& nx) {
    const unsigned G = gridDim.x * gridDim.y * gridDim.z;
    unsigned sum, cnt, mine, sp = 0u;
    for (;;) {
        sum = 0u; cnt = 0u; mine = 0u;
#pragma unroll
        for (unsigned j = 0; j < 16; ++j) { const unsigned c = xb_ld(&bar[XB_XCNT(j)]); sum += c; cnt += (c > 0u) ? 1u : 0u; mine = (j == x) ? c : mine; }
        if (sum == G) break;
        __builtin_amdgcn_s_sleep(1);
        if ((++sp & 255u) == 0u) { if (xb_ld(&bar[XB_TMO])) break; if (sp > XB_SPIN_CAP) { atomicAdd(&bar[XB_TMO], 1u); break; } }
    }
    nloc = mine > 0u ? mine : 1u; nx = cnt > 0u ? cnt : 1u;
}

__device__ __forceinline__ void xcd_barrier(const XcdBarrier& b) {
    asm volatile("s_waitcnt vmcnt(0)" ::: "memory");
    __syncthreads();
    if (threadIdx.x == 0) {
        unsigned* bar = b.bar;
        __builtin_amdgcn_s_waitcnt(0);
        unsigned nloc = b.st[0], nx = b.st[1];
        if (nloc == 0u) { xcd_barrier_complete(bar, b.x, nloc, nx); b.st[0] = nloc; b.st[1] = nx; }
        const unsigned old = xb_add(&bar[XB_XSUB(b.x)], 1u);
        const unsigned gen = old / nloc;
        if (old + 1u == (gen + 1u) * nloc) {
            __builtin_amdgcn_fence(__ATOMIC_RELEASE, "agent");
            asm volatile("s_waitcnt vmcnt(0)" ::: "memory");
            const unsigned og = xb_add(&bar[XB_TOP], 1u);
            const unsigned tg = og / nx;
            if (og + 1u == (tg + 1u) * nx) xb_add(&bar[XB_TOPGEN], 1u);
            else XB_SPIN(xb_ld(&bar[XB_TOPGEN]) == tg, bar);
            __builtin_amdgcn_fence(__ATOMIC_ACQUIRE, "agent");
            xb_add(&bar[XB_XGEN(b.x)], 1u);
            asm volatile("s_waitcnt vmcnt(0)" ::: "memory");
        } else {
            XB_SPIN(xb_ld(&bar[XB_XGEN(b.x)]) == gen, bar);
            __builtin_amdgcn_fence(__ATOMIC_ACQUIRE, "agent");
            asm volatile("s_waitcnt vmcnt(0)" ::: "memory");
        }
    }
    __syncthreads();
}

constexpr size_t MiB = 1u << 20;
constexpr size_t WS_ROPE = 0;
constexpr size_t WS_WL = 1 * MiB;
constexpr size_t WS_XB = 26 * MiB;
constexpr size_t WS_SS0 = 218 * MiB, WS_SS1 = 224 * MiB, WS_SSL = 230 * MiB;
constexpr size_t WS_PB = 236 * MiB;
constexpr size_t WS_TR = 284 * MiB;
constexpr size_t WS_XB2 = WS_TR;
constexpr size_t WS_H = WS_TR;
constexpr size_t WS_PROJ = 812 * MiB;
constexpr size_t WS_QKV = 476 * MiB;
constexpr size_t WS_VTA = 764 * MiB;
constexpr size_t WS_LQ = 476 * MiB, WS_LKV = 548 * MiB, WS_KR = 572 * MiB;
constexpr size_t WS_Q = WS_TR;
constexpr size_t WS_KV = 584 * MiB;
constexpr size_t WS_K = 776 * MiB;
constexpr size_t WS_VTB = 920 * MiB;
constexpr size_t WS_END = 1016 * MiB;
constexpr size_t WS_BAR = WS_END, WS_BAR_BYTES = 16384, WS_TOTAL = WS_BAR + WS_BAR_BYTES;
static_assert(XCD_BAR_WORDS * 4 <= WS_BAR_BYTES, "barrier words");
static_assert(WS_H + (size_t)TT * FFH * 2 <= WS_PROJ && WS_PROJ + (size_t)TT * DM * 2 <= WS_END, "ffn map");
static_assert(WS_XB2 + (size_t)TT * DM * 2 <= WS_QKV && WS_QKV + (size_t)TT * 1536 * 2 <= WS_VTA && WS_VTA + (size_t)TT * 256 * 2 <= WS_PROJ, "mixer A map");
static_assert(WS_LQ + (size_t)TT * 384 * 2 <= WS_LKV && WS_LKV + (size_t)TT * 128 * 2 <= WS_KR && WS_KR + (size_t)TT * 32 * 4 <= WS_KV, "mixer B map 1");
static_assert(WS_Q + (size_t)TH * 1536 * 2 <= WS_LQ && WS_KV + (size_t)TH * 2048 * 2 <= WS_K && WS_K + (size_t)TH * 1536 * 2 <= WS_VTB && WS_VTB + (size_t)TH * 1024 * 2 <= WS_END, "mixer B map 2");
static_assert(WS_XB + (size_t)TT * DM * 2 <= WS_SS0 && WS_PB + (size_t)TT * PLE * 2 <= WS_TR, "fixed map");
constexpr size_t WE = 1u << 20;
constexpr size_t WO_MIX = 0, WO_MIX_O_A = WE * 3 / 2;
constexpr size_t WO_B_UQ = WE * 3 / 4, WO_B_UKV = WE * 21 / 16, WO_B_O = WE * 25 / 16;
constexpr size_t WO_GU = 3 * WE, WO_D = WE * 17 / 2, WO_PG = WE * 45 / 4, WO_PP = WE * 49 / 4, WO_END = WE * 25 / 2;
static_assert(WO_B_UQ == 768u * 1024 && WO_B_UKV == WO_B_UQ + 1536u * 384 && WO_B_O == WO_B_UKV + 2048u * 128 && WO_B_O + WE <= WO_GU, "weight map B");
static_assert(WO_D == WO_GU + 5632u * 1024 && WO_PG == WO_D + 1024u * 2816 && WO_PP == WO_PG + WE && WO_END == WO_PP + 1024u * 256 && WO_END * 2 <= 25 * MiB, "weight map");

constexpr int LDS_BYTES = 131072 + 1024;
__constant__ float INV_FREQ[16] = {1.000000000e+00f, 4.403666258e-01f, 1.939227581e-01f, 8.539710194e-02f, 3.760603070e-02f, 1.656044088e-02f, 7.292665076e-03f, 3.211446106e-03f,
                                   1.414213446e-03f, 6.227724371e-04f, 2.742481884e-04f, 1.207697424e-04f, 5.318296462e-05f, 2.341999789e-05f, 1.031338525e-05f, 4.541670478e-06f};

__device__ __forceinline__ float wave_sum(float v) {
#pragma unroll
    for (int o = 1; o < 64; o <<= 1) v += __shfl_xor(v, o);
    return v;
}
__device__ __forceinline__ void unpack8(const u32x4 w, float* v) { v[0] = bf_lo(w.x); v[1] = bf_hi(w.x); v[2] = bf_lo(w.y); v[3] = bf_hi(w.y); v[4] = bf_lo(w.z); v[5] = bf_hi(w.z); v[6] = bf_lo(w.w); v[7] = bf_hi(w.w); }
__device__ __forceinline__ u32x4 pack8(const float* v) { u32x4 w; w.x = cvt_pk_bf16(v[0], v[1]); w.y = cvt_pk_bf16(v[2], v[3]); w.z = cvt_pk_bf16(v[4], v[5]); w.w = cvt_pk_bf16(v[6], v[7]); return w; }

__device__ __forceinline__ void cvt_item(const float* W, int K, int Nsrc, int Ndst, int mode, const float* gain, bf16_t* dst, LAS float* scr, int it, int lane) {
    const int nblk = Ndst / 32;
    const int kb = it / nblk, nb = it % nblk, k0 = 64 * kb, n0 = 32 * nb;
    int src0;
    if (mode == 1) { const int tile = nb >> 3, w = nb & 7; src0 = (w >> 2) * FFH + tile * 128 + (w & 3) * 32; }
    else src0 = (n0 < Nsrc) ? n0 : -1;
#pragma unroll 8
    for (int i = 0; i < 32; ++i) { const int kk = 2 * i + (lane >> 5); float v = src0 >= 0 ? W[(size_t)(k0 + kk) * Nsrc + src0 + (lane & 31)] : 0.f; if (gain) v *= gain[k0 + kk]; scr[kk * 33 + (lane & 31)] = v; }
    asm volatile("s_waitcnt lgkmcnt(0)" ::: "memory");
    const int c = lane & 7;
#pragma unroll
    for (int j = 0; j < 4; ++j) { const int n = (lane >> 3) + 8 * j; const LAS float* s = scr + (8 * c) * 33 + n;
        u32x4 o; o.x = cvt_pk_bf16(s[0 * 33], s[1 * 33]); o.y = cvt_pk_bf16(s[2 * 33], s[3 * 33]); o.z = cvt_pk_bf16(s[4 * 33], s[5 * 33]); o.w = cvt_pk_bf16(s[6 * 33], s[7 * 33]);
        *(u32x4*)(dst + (size_t)(n0 + n) * K + k0 + 8 * c) = o; }
    asm volatile("s_waitcnt lgkmcnt(0)" ::: "memory");
}
struct Args { const float* in[24]; float* out; unsigned char* ws; int ph_lo, ph_hi; };
__device__ __forceinline__ void cvt_layer(const Args& a, int L, bf16_t* WLp, LAS float* scr, int gw, int NGW, int part  ) {
    int tl = threadIdx.x; asm volatile("" : "+v"(tl)); const int lane = tl & 63;
    const int j = L >> 1; const bool isA = (L & 1) == 0;
    const int n0 = isA ? 768 : 384, n1 = isA ? 512 : 288, n2 = isA ? 0 : 128, n3 = isA ? 0 : 512;
    const int total = n0 + n1 + n2 + n3 + 2816 + 1408 + 512 + 128;
    const int nm = n0 + n1 + n2 + n3; const int it_lo = (part & 1) ? 0 : ((part & 2) ? nm : nm + 4224), it_hi = (part & 4) ? total : ((part & 2) ? nm + 4224 : nm);
    for (int it = it_lo + gw; it < it_hi; it += NGW) {
        int r = it; const float* W; int K, Nsrc, Ndst, mode = 0; const float* gain = nullptr; size_t doff;
        if (r < n0) { if (isA) { W = a.in[5] + (size_t)j * 1024 * 1536; K = 1024; Nsrc = 1536; Ndst = 1536; } else { W = a.in[10] + (size_t)j * 1024 * 544; K = 1024; Nsrc = 544; Ndst = 768; } gain = a.in[4] + L * 1024; doff = WO_MIX; }
        else if ((r -= n0) < n1) { if (isA) { W = a.in[9] + (size_t)j * 1024 * 1024; K = 1024; Nsrc = 1024; Ndst = 1024; doff = WO_MIX_O_A; } else { W = a.in[13] + (size_t)j * 384 * 1536; K = 384; Nsrc = 1536; Ndst = 1536; gain = a.in[11] + j * 384; doff = WO_B_UQ; } }
        else if ((r -= n1) < n2) { W = a.in[14] + (size_t)j * 128 * 2048; K = 128; Nsrc = 2048; Ndst = 2048; gain = a.in[12] + j * 128; doff = WO_B_UKV; }
        else if ((r -= n2) < n3) { W = a.in[17] + (size_t)j * 1024 * 1024; K = 1024; Nsrc = 1024; Ndst = 1024; doff = WO_B_O; }
        else if ((r -= n3) < 2816) { W = a.in[19] + (size_t)L * 1024 * 5632; K = 1024; Nsrc = 5632; Ndst = 5632; mode = 1; gain = a.in[18] + L * 1024; doff = WO_GU; }
        else if ((r -= 2816) < 1408) { W = a.in[20] + (size_t)L * 2816 * 1024; K = 2816; Nsrc = 1024; Ndst = 1024; doff = WO_D; }
        else if ((r -= 1408) < 512) { W = a.in[22] + (size_t)L * 1024 * 1024; K = 1024; Nsrc = 1024; Ndst = 1024; gain = a.in[21] + L * 1024; doff = WO_PG; }
        else { r -= 512; W = a.in[23] + (size_t)L * 256 * 1024; K = 256; Nsrc = 1024; Ndst = 1024; doff = WO_PP; }
        cvt_item(W, K, Nsrc, Ndst, mode, gain, WLp + doff, scr, r, lane);
    }
}

__device__ __forceinline__ int crow(int r, int hi) { return (r & 3) + 8 * (r >> 2) + 4 * hi; }
typedef float f32x2_t __attribute__((ext_vector_type(2))); typedef __bf16 bf16x2_t __attribute__((ext_vector_type(2)));
__device__ __forceinline__ float max3f(float a, float b, float c) { float r; asm("v_max3_f32 %0, %1, %2, %3" : "=v"(r) : "v"(a), "v"(b), "v"(c)); return r; }
__device__ __forceinline__ unsigned cvtpk_s(float lo, float hi) { f32x2_t v = {lo, hi}; bf16x2_t b = __builtin_convertvector(v, bf16x2_t); return __builtin_bit_cast(unsigned, b); }
template <int DQK, bool WIN>
__device__ __forceinline__ void attn_unit(LAS unsigned char* lds, const bf16_t* qrow, bf16_t* orow, const bf16_t* Kb, int ldk, const bf16_t* Vtb, int ldv,
                                          int kt0, int kt1, int qpos, float m_init, float l_init) {
    constexpr int KP = DQK + 8, VP = 72, KBUF = 64 * KP * 2, VBUF = 64 * VP * 2, CPR = DQK / 8, NCH = 64 * CPR, ND = DQK / 16;
    constexpr float THR = 24.f;
    int tid_l = threadIdx.x; asm volatile("" : "+v"(tid_l));
    const int tid = tid_l, lane = tid & 63, r32 = lane & 31, hi = lane >> 5;
    LAS unsigned char* Kl = lds; LAS unsigned char* Vl = lds + 2 * KBUF;
    bf16x8 qf[ND];
#pragma unroll
    for (int d0 = 0; d0 < ND; ++d0) qf[d0] = *(const bf16x8*)(qrow + d0 * 16 + hi * 8);
    f32x16 o0, o1;
#pragma unroll
    for (int r = 0; r < 16; ++r) { o0[r] = 0.f; o1[r] = 0.f; }
    float m = m_init, l = hi == 0 ? l_init : 0.f;
    u32x4 kxa0, kxa1, vxa, kxb0, kxb1, vxb;
    const int c1 = (tid + 512) < NCH ? tid + 512 : tid;
    const int kr0 = tid / CPR, kc0 = tid % CPR, kr1 = c1 / CPR, kc1 = c1 % CPR;
    const int vd = tid >> 3, vcc = tid & 7;
    const int n = kt1 - kt0;
#define ATT_Z16 ((f32x16){0.f, 0.f, 0.f, 0.f, 0.f, 0.f, 0.f, 0.f, 0.f, 0.f, 0.f, 0.f, 0.f, 0.f, 0.f, 0.f})
#define ATT_LOADK(K0_, K1_, t) do { K0_ = *(const u32x4*)(Kb + (size_t)(64 * (t) + kr0) * ldk + kc0 * 8); if (NCH > 512) K1_ = *(const u32x4*)(Kb + (size_t)(64 * (t) + kr1) * ldk + kc1 * 8); } while (0)
#define ATT_LOADV(V_, t) do { V_ = *(const u32x4*)(Vtb + (size_t)vd * ldv + 64 * (t) + vcc * 8); } while (0)
#define ATT_STOREK(K0_, K1_, b) do { *(LAS u32x4*)(Kl + (b) * KBUF + kr0 * (KP * 2) + kc0 * 16) = K0_; if (NCH > 512) *(LAS u32x4*)(Kl + (b) * KBUF + kr1 * (KP * 2) + kc1 * 16) = K1_; } while (0)
#define ATT_STOREV(V_, b) do { *(LAS u32x4*)(Vl + (b) * VBUF + vd * (VP * 2) + vcc * 16) = V_; } while (0)
#define ATT_BAR() do { asm volatile("s_waitcnt lgkmcnt(0)" ::: "memory"); __builtin_amdgcn_s_barrier(); asm volatile("" ::: "memory"); } while (0)
#define ATT_QK(S0, S1, b) do { const LAS unsigned char* kp_ = Kl + (b) * KBUF + r32 * (KP * 2) + hi * 16; \
        _Pragma("unroll") for (int d0 = 0; d0 < ND; ++d0) { const bf16x8 k0_ = *(const LAS bf16x8*)(kp_ + d0 * 32); const bf16x8 k1_ = *(const LAS bf16x8*)(kp_ + 32 * KP * 2 + d0 * 32); \
            if (d0 == 0) { S0 = __builtin_amdgcn_mfma_f32_32x32x16_bf16(k0_, qf[0], ATT_Z16, 0, 0, 0); S1 = __builtin_amdgcn_mfma_f32_32x32x16_bf16(k1_, qf[0], ATT_Z16, 0, 0, 0); } \
            else { S0 = __builtin_amdgcn_mfma_f32_32x32x16_bf16(k0_, qf[d0], S0, 0, 0, 0); S1 = __builtin_amdgcn_mfma_f32_32x32x16_bf16(k1_, qf[d0], S1, 0, 0, 0); } } } while (0)
#define SB_() __builtin_amdgcn_sched_barrier(0)
#define ATT_MAXP(S0, S1, MXV) do { float mx2_ = __builtin_fmaxf(S0[0], S1[0]); \
        _Pragma("unroll") for (int r = 1; r < 16; ++r) mx2_ = __builtin_fmaxf(mx2_, __builtin_fmaxf(S0[r], S1[r])); MXV = mx2_; } while (0)
#define ATT_EXP(idx_, C0, C1) do { if ((idx_) < 16) { C0[(idx_) & 15] = __builtin_amdgcn_exp2f(C0[(idx_) & 15]); ls_ += C0[(idx_) & 15]; } else { C1[(idx_) & 15] = __builtin_amdgcn_exp2f(C1[(idx_) & 15]); ls_ += C1[(idx_) & 15]; } } while (0)
#define ATT_STEP(i_, C0, C1, N0, N1, LK0, LK1, LV, SK0, SK1, SV) do { const int ii_ = (i_); const int b_ = ii_ & 1; constexpr int NG_ = 2 * ND, EQ_ = 24 / NG_; \
        { const int tk_ = (kt0 + ii_ + 3) < kt1 ? (kt0 + ii_ + 3) : (kt1 - 1), tv_ = (kt0 + ii_ + 2) < kt1 ? (kt0 + ii_ + 2) : (kt1 - 1); ATT_LOADK(LK0, LK1, tk_); ATT_LOADV(LV, tv_); } \
        bf16x8 kf_[NG_]; \
        { const LAS unsigned char* kp_ = Kl + (b_ ^ 1) * KBUF + r32 * (KP * 2) + hi * 16; \
          _Pragma("unroll") for (int g = 0; g < ND; ++g) kf_[g] = *(const LAS bf16x8*)(kp_ + (g & 1) * (32 * KP * 2) + (g >> 1) * 32); } \
        SB_(); \
        if (shifted) { _Pragma("unroll") for (int r = 0; r < 16; ++r) { C0[r] -= m; C1[r] -= m; } } \
        if (WIN) { const int kb_ = 64 * (kt0 + ii_) + 4 * hi - qpos; \
            _Pragma("unroll") for (int r = 0; r < 16; ++r) { const int dk_ = kb_ + (r & 3) + 8 * (r >> 2); if (dk_ > 128 || dk_ < -128) C0[r] = -1e30f; if (dk_ + 32 > 128 || dk_ + 32 < -128) C1[r] = -1e30f; } \
            ATT_MAXP(C0, C1, mxc); } \
        float mx_; { auto rr_ = __builtin_amdgcn_permlane32_swap(__float_as_uint(mxc), __float_as_uint(mxc), false, false); mx_ = fmaxf(__uint_as_float(rr_[0]), __uint_as_float(rr_[1])); } \
        if (!WIN) mx_ -= m;     \
        const bool first_ = !WIN && ii_ == 0 && __any(__builtin_fabsf(mx_) > THR); \
        if (first_ || __any(mx_ > THR)) { const float d_ = first_ ? mx_ : fmaxf(mx_, 0.f); m += d_; const float al_ = __builtin_amdgcn_exp2f(-d_); l *= al_; shifted = true; \
            _Pragma("unroll") for (int r = 0; r < 16; ++r) { C0[r] -= d_; C1[r] -= d_; o0[r] *= al_; o1[r] *= al_; } } \
        SB_(); \
        float ls_ = 0.f; bf16x8 vf_[8]; \
        const LAS unsigned char* vp_ = Vl + b_ * VBUF + r32 * (VP * 2) + hi * 16; \
        _Pragma("unroll") for (int g = 0; g < NG_; ++g) { \
            if ((g & 1) == 0) { if (g == 0) N0 = __builtin_amdgcn_mfma_f32_32x32x16_bf16(kf_[0], qf[0], ATT_Z16, 0, 0, 0); else N0 = __builtin_amdgcn_mfma_f32_32x32x16_bf16(kf_[g], qf[g >> 1], N0, 0, 0, 0); } \
            else { if (g == 1) N1 = __builtin_amdgcn_mfma_f32_32x32x16_bf16(kf_[1], qf[0], ATT_Z16, 0, 0, 0); else N1 = __builtin_amdgcn_mfma_f32_32x32x16_bf16(kf_[g], qf[g >> 1], N1, 0, 0, 0); } \
            if (g < ND) { const LAS unsigned char* kp_ = Kl + (b_ ^ 1) * KBUF + r32 * (KP * 2) + hi * 16; kf_[g + ND] = *(const LAS bf16x8*)(kp_ + ((g + ND) & 1) * (32 * KP * 2) + ((g + ND) >> 1) * 32); } \
            if (g >= NG_ - 4) { const int f = g - (NG_ - 4); vf_[f] = *(const LAS bf16x8*)(vp_ + (f & 1) * (32 * VP * 2) + (f >> 1) * 32); } \
            _Pragma("unroll") for (int e = 0; e < EQ_; ++e) ATT_EXP(g * EQ_ + e, C0, C1); \
            SB_(); } \
        u32x4 pw_[4]; \
        pw_[0].x = cvtpk_s(C0[0], C0[1]); pw_[0].y = cvtpk_s(C0[2], C0[3]); pw_[0].z = cvtpk_s(C0[4], C0[5]); pw_[0].w = cvtpk_s(C0[6], C0[7]); \
        SB_(); \
        float mxa_ = 0.f, mxb_ = 0.f; \
        o0 = __builtin_amdgcn_mfma_f32_32x32x16_bf16(vf_[0], __builtin_bit_cast(bf16x8, pw_[0]), o0, 0, 0, 0); \
        pw_[1].x = cvtpk_s(C0[8], C0[9]); pw_[1].y = cvtpk_s(C0[10], C0[11]); ATT_EXP(24, C0, C1); ATT_EXP(25, C0, C1); \
        vf_[4] = *(const LAS bf16x8*)(vp_ + 64); vf_[5] = *(const LAS bf16x8*)(vp_ + (32 * VP * 2) + 64); \
        SB_(); \
        o1 = __builtin_amdgcn_mfma_f32_32x32x16_bf16(vf_[1], __builtin_bit_cast(bf16x8, pw_[0]), o1, 0, 0, 0); \
        pw_[1].z = cvtpk_s(C0[12], C0[13]); pw_[1].w = cvtpk_s(C0[14], C0[15]); ATT_EXP(26, C0, C1); ATT_EXP(27, C0, C1); \
        vf_[6] = *(const LAS bf16x8*)(vp_ + 96); vf_[7] = *(const LAS bf16x8*)(vp_ + (32 * VP * 2) + 96); \
        SB_(); \
        o0 = __builtin_amdgcn_mfma_f32_32x32x16_bf16(vf_[2], __builtin_bit_cast(bf16x8, pw_[1]), o0, 0, 0, 0); \
        pw_[2].x = cvtpk_s(C1[0], C1[1]); pw_[2].y = cvtpk_s(C1[2], C1[3]); ATT_EXP(28, C0, C1); ATT_EXP(29, C0, C1); \
        SB_(); \
        o1 = __builtin_amdgcn_mfma_f32_32x32x16_bf16(vf_[3], __builtin_bit_cast(bf16x8, pw_[1]), o1, 0, 0, 0); \
        pw_[2].z = cvtpk_s(C1[4], C1[5]); pw_[2].w = cvtpk_s(C1[6], C1[7]); ATT_EXP(30, C0, C1); ATT_EXP(31, C0, C1); \
        SB_(); \
        o0 = __builtin_amdgcn_mfma_f32_32x32x16_bf16(vf_[4], __builtin_bit_cast(bf16x8, pw_[2]), o0, 0, 0, 0); \
        pw_[3].x = cvtpk_s(C1[8], C1[9]); pw_[3].y = cvtpk_s(C1[10], C1[11]); \
        if (!WIN) { mxa_ = max3f(N0[0], N1[0], N0[1]); mxb_ = max3f(N1[1], N0[2], N1[2]); mxa_ = max3f(mxa_, N0[3], N1[3]); mxb_ = max3f(mxb_, N0[4], N1[4]); } \
        SB_(); \
        o1 = __builtin_amdgcn_mfma_f32_32x32x16_bf16(vf_[5], __builtin_bit_cast(bf16x8, pw_[2]), o1, 0, 0, 0); \
        pw_[3].z = cvtpk_s(C1[12], C1[13]); pw_[3].w = cvtpk_s(C1[14], C1[15]); \
        if (!WIN) { mxa_ = max3f(mxa_, N0[5], N1[5]); mxb_ = max3f(mxb_, N0[6], N1[6]); mxa_ = max3f(mxa_, N0[7], N1[7]); mxb_ = max3f(mxb_, N0[8], N1[8]); } \
        SB_(); \
        o0 = __builtin_amdgcn_mfma_f32_32x32x16_bf16(vf_[6], __builtin_bit_cast(bf16x8, pw_[3]), o0, 0, 0, 0); \
        if (!WIN) { mxa_ = max3f(mxa_, N0[9], N1[9]); mxb_ = max3f(mxb_, N0[10], N1[10]); mxa_ = max3f(mxa_, N0[11], N1[11]); mxb_ = max3f(mxb_, N0[12], N1[12]); } \
        SB_(); \
        o1 = __builtin_amdgcn_mfma_f32_32x32x16_bf16(vf_[7], __builtin_bit_cast(bf16x8, pw_[3]), o1, 0, 0, 0); \
        if (!WIN) { mxa_ = max3f(mxa_, N0[13], N1[13]); mxb_ = max3f(mxb_, N0[14], N1[14]); mxa_ = max3f(mxa_, N0[15], N1[15]); mxc = fmaxf(mxa_, mxb_); } \
        l += ls_; \
        SB_(); \
        ATT_STOREV(SV, b_ ^ 1); ATT_STOREK(SK0, SK1, b_); \
        ATT_BAR(); } while (0)
    ATT_LOADK(kxa0, kxa1, kt0); ATT_LOADV(vxa, kt0); ATT_STOREK(kxa0, kxa1, 0); ATT_STOREV(vxa, 0);
    { const int t1_ = (kt0 + 1) < kt1 ? (kt0 + 1) : (kt1 - 1); ATT_LOADK(kxa0, kxa1, t1_); ATT_STOREK(kxa0, kxa1, 1); }
    { const int t2_ = (kt0 + 2) < kt1 ? (kt0 + 2) : (kt1 - 1), t1_ = (kt0 + 1) < kt1 ? (kt0 + 1) : (kt1 - 1); ATT_LOADK(kxb0, kxb1, t2_); ATT_LOADV(vxb, t1_); }
    ATT_BAR();
    f32x16 sa0, sa1, sb0, sb1; float mxc = 0.f; bool shifted = (m_init != 0.f);
    ATT_QK(sa0, sa1, 0);
    if (!WIN) ATT_MAXP(sa0, sa1, mxc);
    ATT_BAR();
    int it = 0;
    for (; it + 1 < n; it += 2) { ATT_STEP(it, sa0, sa1, sb0, sb1, kxa0, kxa1, vxa, kxb0, kxb1, vxb); ATT_STEP(it + 1, sb0, sb1, sa0, sa1, kxb0, kxb1, vxb, kxa0, kxa1, vxa); }
    if (it < n) ATT_STEP(it, sa0, sa1, sb0, sb1, kxa0, kxa1, vxa, kxb0, kxb1, vxb);
    asm volatile("s_waitcnt vmcnt(0)" ::: "memory");
#undef ATT_LOADK
#undef ATT_LOADV
#undef ATT_STOREK
#undef ATT_STOREV
#undef ATT_QK
#undef ATT_STEP
#undef ATT_Z16
#undef ATT_MAXP
#undef ATT_EXP
#undef SB_
#undef ATT_BAR
    l += __shfl_xor(l, 32); const float rl = 1.f / l;
#pragma unroll
    for (int g = 0; g < 4; ++g) { u32x2 w; w.x = cvt_pk_bf16(o0[4 * g] * rl, o0[4 * g + 1] * rl); w.y = cvt_pk_bf16(o0[4 * g + 2] * rl, o0[4 * g + 3] * rl); *(u32x2*)(orow + 8 * g + 4 * hi) = w;
        w.x = cvt_pk_bf16(o1[4 * g] * rl, o1[4 * g + 1] * rl); w.y = cvt_pk_bf16(o1[4 * g + 2] * rl, o1[4 * g + 3] * rl); *(u32x2*)(orow + 32 + 8 * g + 4 * hi) = w; }
}

__device__ __forceinline__ void pb_chunk(const float* pp, const float* ps, int layer, bf16_t* PB, int tok0, int tid) {
    f32x4 v[8];
#pragma unroll
    for (int k = 0; k < 8; ++k) { const int idx4 = tid + 512 * k, tok = tok0 + (idx4 >> 6), c4 = idx4 & 63; const int e = ext_row(tok);
        const float* src = e < 65536 ? pp + ((size_t)layer * 65536 + e) * PLE : ps + ((size_t)layer * 32768 + (e - 65536)) * PLE;
        v[k] = *(const f32x4*)(src + c4 * 4); }
#pragma unroll
    for (int k = 0; k < 8; ++k) { const int idx4 = tid + 512 * k, tok = tok0 + (idx4 >> 6), c4 = idx4 & 63;
        u32x2 w; w.x = cvt_pk_bf16(v[k][0], v[k][1]); w.y = cvt_pk_bf16(v[k][2], v[k][3]); *(u32x2*)(PB + (size_t)tok * PLE + c4 * 4) = w; }
}
__device__ __forceinline__ void fixup_a(LAS unsigned char* lds, bf16_t* QKV, bf16_t* VtA, const float* qg, const float* kg, const f32x2* rope, int vcu, int G,
                                        const float* pp, const float* ps, int layer, bf16_t* PB) {
    int tid_l = threadIdx.x; asm volatile("" : "+v"(tid_l));
    const int tid = tid_l, lane = tid & 63, wid = tid >> 6, sub = lane & 7, hl = lane >> 3;
    LAS bf16_t* vt = (LAS bf16_t*)lds;
    for (int chunk = vcu; chunk < TT / 64; chunk += G) {
        const int tok0 = chunk * 64; int st, S; seq_of(tok0, st, S);
        for (int ib = 0; ib < 2; ++ib) {
            u32x4 rawb[4][3]; f32x2 csb[4][8];
#pragma unroll
            for (int t = 0; t < 4; ++t) { const int tok = tok0 + wid * 8 + ib * 4 + t, pos = tok - st; const bf16_t* rowp = QKV + (size_t)tok * 1536;
#pragma unroll
                for (int rr = 0; rr < 3; ++rr) rawb[t][rr] = *(const u32x4*)(rowp + (rr * 8 + hl) * 64 + sub * 8);
#pragma unroll
                for (int e = 0; e < 8; ++e) csb[t][e] = rope[pos * 16 + 2 * e]; }
#pragma unroll
            for (int t = 0; t < 4; ++t) { const int i = ib * 4 + t; const int tok = tok0 + wid * 8 + i; bf16_t* rowp = QKV + (size_t)tok * 1536;
#pragma unroll
                for (int rr = 0; rr < 3; ++rr) { const int hh = rr * 8 + hl; const u32x4 raw = rawb[t][rr];
                    float v[8]; unpack8(raw, v);
                    float ss = 0.f;
#pragma unroll
                    for (int e = 0; e < 8; ++e) ss += v[e] * v[e];
                    ss += __shfl_xor(ss, 1); ss += __shfl_xor(ss, 2); ss += __shfl_xor(ss, 4);
                    const float rs = __builtin_amdgcn_rsqf(ss * (1.f / 64.f) + EPS);
                    const float* g = hh < 16 ? qg : kg;
                    float pv[8];
#pragma unroll
                    for (int e = 0; e < 8; ++e) { v[e] = v[e] * rs * g[sub * 8 + e]; pv[e] = __shfl_xor(v[e], 1); }
                    if (sub < 2) {
#pragma unroll
                        for (int e = 0; e < 8; ++e) { const f32x2 cs = csb[t][e]; v[e] = sub == 0 ? v[e] * cs.x - pv[e] * cs.y : pv[e] * cs.y + v[e] * cs.x; } }
                    if (hh < 16) {
#pragma unroll
                        for (int e = 0; e < 8; ++e) v[e] *= 0.125f * LOG2E; }
                    if (hh < 20) *(u32x4*)(rowp + hh * 64 + sub * 8) = pack8(v);
                    else { const int hv = hh - 20; const unsigned w[4] = {raw.x, raw.y, raw.z, raw.w};
#pragma unroll
                        for (int e = 0; e < 8; ++e) vt[(hv * 64 + sub * 8 + e) * 72 + wid * 8 + i] = (bf16_t)((e & 1) ? (w[e >> 1] >> 16) : (w[e >> 1] & 0xffffu)); } } } }
        __syncthreads();
#pragma unroll
        for (int k = 0; k < 4; ++k) { const int c = tid + 512 * k, row = c >> 3, cc = c & 7, hv = row >> 6, d = row & 63;
            const u32x2 d0_ = *(const LAS u32x2*)(vt + row * 72 + (cc >> 1) * 16 + (cc & 1) * 4), d1_ = *(const LAS u32x2*)(vt + row * 72 + (cc >> 1) * 16 + 8 + (cc & 1) * 4);
            u32x4 dat; dat.x = d0_.x; dat.y = d0_.y; dat.z = d1_.x; dat.w = d1_.y;
            *(u32x4*)(VtA + (size_t)st * 256 + (size_t)hv * 64 * S + (size_t)d * S + (tok0 - st) + cc * 8) = dat; }
        pb_chunk(pp, ps, layer, PB, tok0, tid);
        __syncthreads();
    }
}
__device__ __forceinline__ void fixup_b(LAS unsigned char* lds, const bf16_t* Q, bf16_t* Qo, const bf16_t* KV, const float* KR, bf16_t* K, bf16_t* VtB, const float* qg, const float* kg, const f32x2* rope,
                                        int hf, int vcu, int G) {
    int tid_l = threadIdx.x; asm volatile("" : "+v"(tid_l));
    const int tid = tid_l, lane = tid & 63, wid = tid >> 6, sub = lane & 7, hl = lane >> 3;
    LAS bf16_t* vt = (LAS bf16_t*)lds;
    const float qscale = 0.10206207261596575f * LOG2E;
    for (int chunk = vcu; chunk < TH / 32; chunk += G) {
        const int lt0 = chunk * 32; int st, S; seq_of(hf * TH + lt0, st, S); const int lst = st - hf * TH;
        for (int ib = 0; ib < 2; ++ib) {
            f32x2 csb[2][4]; f32x4 krb[2]; u32x4 qn[2][2], kn[2][2], vn[2][2]; u32x2 qr2[2][2];
#pragma unroll
            for (int t = 0; t < 2; ++t) { const int lt = lt0 + wid * 4 + ib * 2 + t, pos = lt - lst; const int fi = 4 * (sub & 3);
#pragma unroll
                for (int e = 0; e < 4; ++e) csb[t][e] = rope[pos * 16 + fi + e];
                krb[t] = *(const f32x4*)(KR + (size_t)lt * 32 + sub * 4);
#pragma unroll
                for (int rr = 0; rr < 2; ++rr) { const int h = rr * 8 + hl; const bf16_t* qp = Q + (size_t)lt * 1536 + h * 96; const bf16_t* kvp = KV + (size_t)lt * 2048 + h * 128;
                    qn[t][rr] = *(const u32x4*)(qp + sub * 8); qr2[t][rr] = *(const u32x2*)(qp + 64 + sub * 4); kn[t][rr] = *(const u32x4*)(kvp + sub * 8); vn[t][rr] = *(const u32x4*)(kvp + 64 + sub * 8); } }
#pragma unroll
            for (int t = 0; t < 2; ++t) { const int i = ib * 2 + t; const int lt = lt0 + wid * 4 + i; const f32x4 krv = krb[t];
#pragma unroll
                for (int rr = 0; rr < 2; ++rr) { const int h = rr * 8 + hl;
                    {
                        bf16_t* qp = Qo + (size_t)lt * 1536 + h * 96; const u32x4 rn = qn[t][rr]; const u32x2 rr2 = qr2[t][rr];
                        float a[8]; unpack8(rn, a); float b[4] = {bf_lo(rr2.x), bf_hi(rr2.x), bf_lo(rr2.y), bf_hi(rr2.y)};
                        float ss = 0.f;
#pragma unroll
                        for (int e = 0; e < 8; ++e) ss += a[e] * a[e];
#pragma unroll
                        for (int e = 0; e < 4; ++e) ss += b[e] * b[e];
                        ss += __shfl_xor(ss, 1); ss += __shfl_xor(ss, 2); ss += __shfl_xor(ss, 4);
                        const float rs = __builtin_amdgcn_rsqf(ss * (1.f / 96.f) + EPS);
#pragma unroll
                        for (int e = 0; e < 8; ++e) a[e] = a[e] * rs * qg[sub * 8 + e] * qscale;
#pragma unroll
                        for (int e = 0; e < 4; ++e) { b[e] = b[e] * rs * qg[64 + sub * 4 + e]; const float pb = __shfl_xor(b[e], 4);
                            b[e] = (sub < 4 ? b[e] * csb[t][e].x - pb * csb[t][e].y : pb * csb[t][e].y + b[e] * csb[t][e].x) * qscale; }
                        *(u32x4*)(qp + sub * 8) = pack8(a); u32x2 w; w.x = cvt_pk_bf16(b[0], b[1]); w.y = cvt_pk_bf16(b[2], b[3]); *(u32x2*)(qp + 64 + sub * 4) = w;
                    }
                    {
                        const u32x4 rn = kn[t][rr]; const u32x4 rv = vn[t][rr];
                        float a[8]; unpack8(rn, a); float b[4] = {krv[0], krv[1], krv[2], krv[3]};
                        float ss = 0.f;
#pragma unroll
                        for (int e = 0; e < 8; ++e) ss += a[e] * a[e];
#pragma unroll
                        for (int e = 0; e < 4; ++e) ss += b[e] * b[e];
                        ss += __shfl_xor(ss, 1); ss += __shfl_xor(ss, 2); ss += __shfl_xor(ss, 4);
                        const float rs = __builtin_amdgcn_rsqf(ss * (1.f / 96.f) + EPS);
#pragma unroll
                        for (int e = 0; e < 8; ++e) a[e] = a[e] * rs * kg[sub * 8 + e];
#pragma unroll
                        for (int e = 0; e < 4; ++e) { b[e] = b[e] * rs * kg[64 + sub * 4 + e]; const float pb = __shfl_xor(b[e], 4);
                            b[e] = sub < 4 ? b[e] * csb[t][e].x - pb * csb[t][e].y : pb * csb[t][e].y + b[e] * csb[t][e].x; }
                        bf16_t* kp = K + (size_t)lt * 1536 + h * 96;
                        *(u32x4*)(kp + sub * 8) = pack8(a); u32x2 w; w.x = cvt_pk_bf16(b[0], b[1]); w.y = cvt_pk_bf16(b[2], b[3]); *(u32x2*)(kp + 64 + sub * 4) = w;
                        const unsigned wv[4] = {rv.x, rv.y, rv.z, rv.w};
#pragma unroll
                        for (int e = 0; e < 8; ++e) vt[(h * 64 + sub * 8 + e) * 40 + wid * 4 + i] = (bf16_t)((e & 1) ? (wv[e >> 1] >> 16) : (wv[e >> 1] & 0xffffu));
                    } } } }
        __syncthreads();
#pragma unroll
        for (int k = 0; k < 8; ++k) { const int c = tid + 512 * k, row = c >> 2, cc = c & 3, h = row >> 6, d = row & 63;
            const u32x2 d0_ = *(const LAS u32x2*)(vt + row * 40 + (cc >> 1) * 16 + (cc & 1) * 4), d1_ = *(const LAS u32x2*)(vt + row * 40 + (cc >> 1) * 16 + 8 + (cc & 1) * 4);
            u32x4 dat; dat.x = d0_.x; dat.y = d0_.y; dat.z = d1_.x; dat.w = d1_.y;
            *(u32x4*)(VtB + (size_t)lst * 1024 + (size_t)h * 64 * S + (size_t)d * S + (lt0 - lst) + cc * 8) = dat; }
        __syncthreads();
    }
}


__global__ void __launch_bounds__(512, 2) mega(Args a) {
    extern __shared__ __attribute__((aligned(16))) unsigned char lds_raw[];
    LAS unsigned char* lds = (LAS unsigned char*)lds_raw;
    cg::grid_group grid = cg::this_grid();
    const int tid = threadIdx.x, lane = tid & 63, wid = __builtin_amdgcn_readfirstlane(tid >> 6);
    const int G = gridDim.x, bx = blockIdx.x, vcu = (G % 8 == 0) ? (bx % 8) * (G / 8) + bx / 8 : bx;
    const int gw = vcu * 8 + wid, NGW = G * 8;
#define ROPE ((f32x2*)(ws + WS_ROPE))
#define WL ((bf16_t*)(ws + WS_WL))
#define XB ((bf16_t*)(ws + WS_XB))
#define XB2 ((bf16_t*)(ws + WS_XB2))
#define SSV0 ((float*)(ws + WS_SS0))
#define SSV1 ((float*)(ws + WS_SS1))
#define SSL ((float*)(ws + WS_SSL))
#define PB ((bf16_t*)(ws + WS_PB))
#define Hb ((bf16_t*)(ws + WS_H))
#define PROJ ((bf16_t*)(ws + WS_PROJ))
#define QKV ((bf16_t*)(ws + WS_QKV))
#define VTA ((bf16_t*)(ws + WS_VTA))
#define LQ ((bf16_t*)(ws + WS_LQ))
#define LKV ((bf16_t*)(ws + WS_LKV))
#define KR ((float*)(ws + WS_KR))
#define Qh ((bf16_t*)(ws + WS_Q))
#define KVh ((bf16_t*)(ws + WS_KV))
#define Kh ((bf16_t*)(ws + WS_K))
#define VTB ((bf16_t*)(ws + WS_VTB))
#define SSa (s ? SSV1 : SSV0)
#define SSb (s ? SSV0 : SSV1)
    float* X = a.out;
    LAS float* scr = (LAS float*)(lds + wid * 16384);
    if (tid < 2) ((LAS unsigned*)(lds + 131072))[tid] = 0u;
    __syncthreads();
    const XcdBarrier xbar = xcd_barrier_post((unsigned*)(a.ws + WS_BAR), (volatile LAS unsigned*)(lds + 131072));
    int ph = 0; const int lo = a.ph_lo, hi = a.ph_hi;
#define PH_BEGIN if (ph >= lo && ph < hi) { unsigned char* ws = a.ws; asm volatile("" : "+s"(ws));
#define PH_END   if (ph + 1 < hi) { if (ph == 0) grid.sync(); else xcd_barrier(xbar); } } ++ph;
#define CVT_LAYER(L, part) cvt_layer(a, (L), WL, scr, gw, NGW, (part))
#ifndef EN
#define EN 0xffff
#endif
#ifndef DUP
#define DUP 0
#endif
#define REP(bit) for (int rep_ = ((DUP & (bit)) ? 0 : 1); rep_ < 2; ++rep_)
#define AMUL ((float)rep_)
#define GEMM(EpiT, g, E) do { pg8::StaticOrder S_; S_.init((g).M, (g).N, G, bx); pg8::gemm_phase<EpiT, pg8::StaticOrder, true, true>(lds, (g), S_, (E)); } while (0)

    PH_BEGIN

#if EN & 4096
        for (int idx = (vcu * 512 + tid); idx < 8192 * 16; idx += G * 512) { const int pos = idx >> 4, i = idx & 15; const float ang = (float)pos * INV_FREQ[i];
            double rev = (double)ang * 0.15915494309189535; rev -= __builtin_rint(rev); const float rf = (float)rev;
            f32x2 cs; cs.x = __builtin_amdgcn_cosf(rf); cs.y = __builtin_amdgcn_sinf(rf); ROPE[idx] = cs; }
        REP(4096) for (int row0 = gw * 4; row0 < TT; row0 += NGW * 4) {
            f32x4 v[4][4];
#pragma unroll
            for (int t = 0; t < 4; ++t) { const int e = ext_row(row0 + t); const float* src = e < 65536 ? a.in[0] + (size_t)e * DM : a.in[1] + (size_t)(e - 65536) * DM;
#pragma unroll
                for (int j = 0; j < 4; ++j) v[t][j] = *(const f32x4*)(src + (64 * j + lane) * 4); }
#pragma unroll
            for (int t = 0; t < 4; ++t) { const int row = row0 + t, e = ext_row(row); float s = 0.f;
#pragma unroll
                for (int j = 0; j < 4; ++j) s += (v[t][j][0] * v[t][j][0] + v[t][j][1] * v[t][j][1]) + (v[t][j][2] * v[t][j][2] + v[t][j][3] * v[t][j][3]);
                s = wave_sum(s);
#pragma unroll
                for (int j = 0; j < 4; ++j) { *(f32x4*)(X + (size_t)e * DM + (64 * j + lane) * 4) = v[t][j]; u32x2 w; w.x = cvt_pk_bf16(v[t][j][0], v[t][j][1]); w.y = cvt_pk_bf16(v[t][j][2], v[t][j][3]);
                    *(u32x2*)(XB2 + (size_t)row * DM + (64 * j + lane) * 4) = w; }
                if (lane < 16) SSV0[(size_t)row * 16 + lane] = lane == 0 ? s : 0.f; } }
        CVT_LAYER(0, 7);
#endif

    PH_END

#pragma nounroll
    for (int layer = 0; layer < 4; ++layer) {
        const int j = layer >> 1, s = layer & 1;
        if ((layer & 1) == 0) {
            PH_BEGIN
#if EN & 1
REP(1) { pg8::Gemm g{XB2, WL + WO_MIX, TT, 1536, 1024, 1024, 1024}; pg8::EpiScale E{QKV, 1536, pg8::RowScale{SSa, 0, 4, 1.f / 1024.f}}; GEMM(pg8::EpiScale, g, E); }
#endif
 if (layer > 0) CVT_LAYER(layer, 4); PH_END
            PH_BEGIN
#if EN & 2
fixup_a(lds, QKV, VTA, a.in[6] + j * 64, a.in[7] + j * 64, ROPE, vcu, G, a.in[2], a.in[3], layer, PB);
#endif
 PH_END
            PH_BEGIN

#if EN & 4
                int tl_ = threadIdx.x; asm volatile("" : "+v"(tl_)); const int lane = tl_ & 63, wid = __builtin_amdgcn_readfirstlane(tl_ >> 6);
                REP(4)
                for (int u = vcu; u < 6144; u += G) { const int psel = u & 1, rest = u >> 1, blk = rest % 768, kvh = rest / 768; const int tok0 = blk * 128; int st, S; seq_of(tok0, st, S);
                    const int n = (tok0 - st) >> 7, nt = S >> 6, kt0 = (2 * n - 2) > 0 ? (2 * n - 2) : 0, kt1 = (2 * n + 4) < nt ? (2 * n + 4) : nt;
                    const int head = kvh * 4 + psel * 2 + (wid >> 2), qpos = (n << 7) + (wid & 3) * 32 + (lane & 31);
                    bf16_t* qrow = QKV + (size_t)(st + qpos) * 1536 + head * 64;
                    const float sk2_ = a.in[8][j * 16 + head] * LOG2E; const bool sks_ = __builtin_fabsf(sk2_) <= 24.f; const float sk_m = sks_ ? 0.f : sk2_, sk_l = sks_ ? __builtin_amdgcn_exp2f(sk2_) : 1.f;
                    attn_unit<64, true>(lds, qrow, rep_ ? qrow : PROJ + (size_t)(st + qpos) * 1024 + head * 64, QKV + (size_t)st * 1536 + 1024 + kvh * 64, 1536, VTA + (size_t)st * 256 + (size_t)kvh * 64 * S, S, kt0, kt1, qpos,
                                        sk_m, sk_l); }
#endif

            PH_END
            PH_BEGIN
#if EN & 8
REP(8) { pg8::Gemm g{QKV, WL + WO_MIX_O_A, TT, 1024, 1024, 1536, 1024}; pg8::EpiResid<false> E{X, 0, XB, SSb, nullptr, pg8::RowScale{nullptr, 0, 0, 0.f}, AMUL}; GEMM(pg8::EpiResid<false>, g, E); }
#endif
 PH_END
        } else {
            PH_BEGIN
#if EN & 16
REP(16) { pg8::Gemm g{XB2, WL + WO_MIX, TT, 768, 1024, 1024, 1024}; pg8::EpiLat E{LQ, LKV, KR, SSL, pg8::RowScale{SSa, 0, 4, 1.f / 1024.f}}; GEMM(pg8::EpiLat, g, E); }
#endif
 CVT_LAYER(layer, 4); PH_END
#pragma nounroll
            for (int hf = 0; hf < 2; ++hf) {
                PH_BEGIN

#if EN & 32
                    REP(32) { pg8::Gemm g{LQ + (size_t)hf * TH * 384, WL + WO_B_UQ, TH, 1536, 384, 384, 384}; pg8::EpiScale E{Qh, 1536, pg8::RowScale{SSL + (size_t)hf * TH * 16, 0, 2, 1.f / 384.f}}; GEMM(pg8::EpiScale, g, E); }
                    REP(32) { pg8::Gemm g{LKV + (size_t)hf * TH * 128, WL + WO_B_UKV, TH, 2048, 128, 128, 128}; pg8::EpiScale E{KVh, 2048, pg8::RowScale{SSL + (size_t)hf * TH * 16, 8, 1, 1.f / 128.f}}; GEMM(pg8::EpiScale, g, E); }
#endif

                PH_END
                PH_BEGIN

#if EN & 64
                    REP(64) fixup_b(lds, Qh, rep_ ? Qh : Kh, KVh, KR + (size_t)hf * TH * 32, Kh, VTB, a.in[15] + j * 96, a.in[16] + j * 96, ROPE, hf, vcu, G);
                    if (hf == 0) { int tp_ = threadIdx.x; asm volatile("" : "+v"(tp_)); for (int chunk = vcu; chunk < TT / 64; chunk += G) pb_chunk(a.in[2], a.in[3], layer, PB, chunk * 64, tp_); }
#endif

                PH_END
                PH_BEGIN

#if EN & 128
                    int tl_ = threadIdx.x; asm volatile("" : "+v"(tl_)); const int lane = tl_ & 63, wid = __builtin_amdgcn_readfirstlane(tl_ >> 6);
                    REP(128)
                    for (int u = vcu; u < 3072; u += G) { int sq0, S, h, qb;
                        if (u < 2048) { const int pair = u >> 5; qb = u & 31; S = 8192; sq0 = (pair >> 4) * 8192; h = pair & 15; }
                        else { const int v = u - 2048, pair = v >> 3; qb = v & 7; S = 2048; sq0 = 32768 + (pair >> 4) * 2048; h = pair & 15; }
                        const size_t qr = (size_t)(sq0 + qb * 256 + wid * 32 + (lane & 31));
                        attn_unit<96, false>(lds, Qh + qr * 1536 + h * 96, KVh + qr * 1024 + h * 64, Kh + (size_t)sq0 * 1536 + h * 96, 1536, VTB + (size_t)sq0 * 1024 + (size_t)h * 64 * S, S, 0, S >> 6, 0, 0.f, 0.f); }
#endif

                PH_END
                PH_BEGIN
#if EN & 256
REP(256) { pg8::Gemm g{KVh, WL + WO_B_O, TH, 1024, 1024, 1024, 1024}; pg8::EpiResid<false> E{X, hf * TH, XB + (size_t)hf * TH * DM, SSb + (size_t)hf * TH * 16, nullptr, pg8::RowScale{nullptr, 0, 0, 0.f}, AMUL}; GEMM(pg8::EpiResid<false>, g, E); }
#endif
 PH_END
            }
        }
        PH_BEGIN
#if EN & 512
REP(512) { pg8::Gemm g{XB, WL + WO_GU, TT, 5632, 1024, 1024, 1024}; pg8::EpiSwiglu E{Hb, pg8::RowScale{SSb, 0, 4, 1.f / 1024.f}}; GEMM(pg8::EpiSwiglu, g, E); }
#endif
 if (layer < 3) CVT_LAYER(layer + 1, 1); PH_END
        PH_BEGIN

#if EN & 1024
            REP(1024) { pg8::Gemm g{Hb, WL + WO_D, TT, 1024, FFH, FFH, FFH}; pg8::EpiResid<false> E{X, 0, XB, SSa, nullptr, pg8::RowScale{nullptr, 0, 0, 0.f}, AMUL}; GEMM(pg8::EpiResid<false>, g, E); }
            REP(1024) { pg8::Gemm g{PB, WL + WO_PP, TT, 1024, PLE, PLE, PLE}; pg8::EpiScale E{PROJ, 1024, pg8::RowScale{nullptr, 0, 0, 0.f}}; GEMM(pg8::EpiScale, g, E); }
#endif

        PH_END
        PH_BEGIN
#if EN & 2048
REP(2048) { pg8::Gemm g{XB, WL + WO_PG, TT, 1024, 1024, 1024, 1024}; pg8::EpiResid<true> E{X, 0, XB2, SSb, PROJ, pg8::RowScale{SSa, 0, 4, 1.f / 1024.f}, AMUL}; GEMM(pg8::EpiResid<true>, g, E); }
#endif
 if (layer < 3) CVT_LAYER(layer + 1, 2); PH_END
    }
}

#ifndef N_LAUNCH_MODE
#define N_LAUNCH_MODE 1
#endif
constexpr int NPH = 39;
extern "C" void kernel_launch(void* const* d_in, const int* in_sizes, int n_in, void* d_out, int out_size, void* d_ws, size_t ws_size, hipStream_t stream) {
    static int grid = 0;
    if (grid == 0) {
        if (n_in != 24 || out_size != TT * DM || ws_size < WS_TOTAL) { fprintf(stderr, "kernel_launch: unexpected sizes n_in %d out %d ws %zu (need %zu)\n", n_in, out_size, ws_size, (size_t)WS_TOTAL); grid = -1; return; }
        int dev = 0, cus = 0, per_cu = 0;
        (void)hipGetDevice(&dev); (void)hipDeviceGetAttribute(&cus, hipDeviceAttributeMultiprocessorCount, dev);
        if (hipFuncSetAttribute((const void*)mega, hipFuncAttributeMaxDynamicSharedMemorySize, LDS_BYTES) != hipSuccess) { fprintf(stderr, "kernel_launch: hipFuncSetAttribute failed\n"); grid = -1; return; }
        if (hipOccupancyMaxActiveBlocksPerMultiprocessor(&per_cu, (const void*)mega, 512, LDS_BYTES) != hipSuccess || per_cu < 1) { fprintf(stderr, "kernel_launch: occupancy query %d\n", per_cu); per_cu = 1; }
        (void)hipGetLastError();
        grid = cus * 1;
        if (grid <= 0) grid = 256;
    }
    if (grid < 0) return;
    if (hipMemsetAsync((char*)d_ws + WS_BAR, 0, WS_BAR_BYTES, stream) != hipSuccess) { fprintf(stderr, "kernel_launch: memset failed\n"); return; }
    Args a{};
    for (int i = 0; i < 24; ++i) a.in[i] = (const float*)d_in[i];
    a.out = (float*)d_out; a.ws = (unsigned char*)d_ws;
#if N_LAUNCH_MODE == 1
    a.ph_lo = 0; a.ph_hi = 1 << 20;
    void* args[] = {&a};
    hipError_t e = hipLaunchCooperativeKernel((const void*)mega, dim3(grid), dim3(512), args, LDS_BYTES, stream);
    if (e != hipSuccess) fprintf(stderr, "cooperative launch failed: %s (grid %d)\n", hipGetErrorString(e), grid);
#else
    for (int p = 0; p < NPH; ++p) { a.ph_lo = p; a.ph_hi = p + 1; hipLaunchKernelGGL(mega, dim3(grid), dim3(512), LDS_BYTES, stream, a); }
#endif
}
```

```cpp
#include <hip/hip_runtime.h>
#include <hip/hip_cooperative_groups.h>
#include <cstdio>
#include <cstdint>
namespace cg = cooperative_groups;

constexpr int TT = 98304;
constexpr int TH = 49152;
constexpr int DM = 1024, FFH = 2816, PLE = 256;
constexpr float EPS = 1e-6f;
constexpr float LOG2E = 1.4426950408889634f;

__device__ __forceinline__ int ext_row(int r) { const int h = r >= TH ? 1 : 0; const int o = r - h * TH; return o < 32768 ? h * 32768 + o : 65536 + h * 16384 + (o - 32768); }
__device__ __forceinline__ void seq_of(int tok, int& st, int& S) { const int h = tok >= TH ? 1 : 0; const int o = tok - h * TH;
    if (o < 32768) { S = 8192; st = h * TH + (o & ~8191); } else { S = 2048; st = h * TH + 32768 + ((o - 32768) & ~2047); } }

namespace pg8 {
#define PG8_LAS __attribute__((address_space(3)))
typedef unsigned short bf16_t;
typedef short bf16x8 __attribute__((ext_vector_type(8)));
typedef float f32x4 __attribute__((ext_vector_type(4)));
typedef unsigned u32x4 __attribute__((ext_vector_type(4)));
constexpr int BM = 256, BK = 64, HALF = 128, HTB = HALF * BK * 2  , STAGE_BYTES = 8 * HTB, NXCD = 8, WGM = 8;

__host__ __device__ __forceinline__ int lds_byte(int r, int c) { const int st = (r >> 4) * 2 + (c >> 5), rr = r & 15, cc = c & 31, ob = rr * 64 + cc * 2; return st * 1024 + (ob ^ (((ob >> 9) & 1) << 5)); }
__host__ __device__ __forceinline__ void stage_rc(int b, int& R, int& C) { const int st = b / 1024, sb = b % 1024, swz = sb ^ (((sb >> 9) & 1) << 5); R = (st >> 1) * 16 + swz / 64; C = (st & 1) * 32 + (swz % 64) / 2; }
__host__ __device__ __forceinline__ int perm32(int rho) { const int n = rho >> 4, i = rho & 15; return 8 * (i >> 2) + 4 * n + (i & 3); }

struct Unit { int pm, pn; };
struct Gemm { const bf16_t* A; const bf16_t* Bt; int M, N, K, lda, ldb; };

struct StaticOrder {
    int nM, nN, nwg, G, c;
    __host__ __device__ void init(int M, int N, int G_, int c_) { nM = M / BM; nN = N / BM; nwg = nM * nN; G = G_; c = c_; }
    __host__ __device__ bool next(int i, Unit& u) const {
        const long L = (long)i * G + c; if (L >= nwg) return false;
        int wgid = (int)L; { const int q = nwg / NXCD, r = nwg % NXCD, xcd = wgid % NXCD, off = wgid / NXCD; wgid = (xcd < r ? xcd * (q + 1) : r * (q + 1) + (xcd - r) * q) + off; }
        const int nig = WGM * nN, gid = wgid / nig, fm = gid * WGM, gsz = (nM - fm) < WGM ? (nM - fm) : WGM;
        u.pm = fm + ((wgid % nig) % gsz); u.pn = (wgid % nig) / gsz; return true;
    }
    __device__ __forceinline__ void a_ready(const Unit&) const {}
    __device__ __forceinline__ void done(const Unit&) const {}
};

__device__ __forceinline__ unsigned cvt_pk_bf16(float lo, float hi) { unsigned r; asm volatile("v_cvt_pk_bf16_f32 %0, %1, %2" : "=v"(r) : "v"(lo), "v"(hi)); return r; }
typedef unsigned u32x2 __attribute__((ext_vector_type(2)));
__device__ __forceinline__ float bf_lo(unsigned w) { return __uint_as_float(w << 16); }
__device__ __forceinline__ float bf_hi(unsigned w) { return __uint_as_float(w & 0xffff0000u); }

struct RowScale { const float* ss; int s0, ns4; float inv_dim;
    __device__ __forceinline__ float get(int row) const {
        if (!ss) return 1.f;
        const f32x4* p = (const f32x4*)(ss + (size_t)row * 16 + s0); float s = 0.f;
        for (int i = 0; i < ns4; ++i) { const f32x4 v = p[i]; s += (v[0] + v[1]) + (v[2] + v[3]); }
        return __builtin_amdgcn_rsqf(s * inv_dim + EPS);
    } };

struct EpiScale {
    static constexpr bool PERM = true, AFTER_DRAIN = false;
    bf16_t* O; int ldc; RowScale rs;
    __device__ __forceinline__ void operator()(const f32x4 (&acc)[2][2][4][2], const Unit& u, int wr, int wc, int fr, int fq) const {
        const int row0 = u.pm * BM + wr * 64 + fr, col0 = u.pn * BM + wc * 32 + 8 * fq;
#pragma unroll
        for (int ai = 0; ai < 2; ++ai)
#pragma unroll
            for (int m = 0; m < 4; ++m) { const int row = row0 + ai * HALF + m * 16; const float s = rs.get(row); bf16_t* rp = O + (size_t)row * ldc + col0;
#pragma unroll
                for (int bj = 0; bj < 2; ++bj) { const f32x4 v0 = acc[ai][bj][m][0] * s, v1 = acc[ai][bj][m][1] * s; u32x4 w; w.x = cvt_pk_bf16(v0[0], v0[1]); w.y = cvt_pk_bf16(v0[2], v0[3]); w.z = cvt_pk_bf16(v1[0], v1[1]); w.w = cvt_pk_bf16(v1[2], v1[3]);
                    *(u32x4*)(rp + bj * HALF) = w; } }
    }
};

struct EpiLat {
    static constexpr bool PERM = false, AFTER_DRAIN = false;
    bf16_t* LQ; bf16_t* LKV; float* KR; float* SSL; RowScale rs;
    __device__ __forceinline__ void operator()(const f32x4 (&acc)[2][2][4][2], const Unit& u, int wr, int wc, int fr, int fq) const {
        const int row0 = u.pm * BM + wr * 64 + fr, col0 = u.pn * BM + wc * 32 + 4 * fq;
#pragma unroll
        for (int ai = 0; ai < 2; ++ai)
#pragma unroll
            for (int m = 0; m < 4; ++m) { const int row = row0 + ai * HALF + m * 16; const float s = rs.get(row); float q[2] = {0.f, 0.f};
#pragma unroll
                for (int bj = 0; bj < 2; ++bj)
#pragma unroll
                    for (int n = 0; n < 2; ++n) { const f32x4 v = acc[ai][bj][m][n] * s; q[bj] += (v[0] * v[0] + v[1] * v[1]) + (v[2] * v[2] + v[3] * v[3]);
                        const int col = col0 + bj * HALF + n * 16; u32x2 w; w.x = cvt_pk_bf16(v[0], v[1]); w.y = cvt_pk_bf16(v[2], v[3]);
                        if (col < 384) *(u32x2*)(LQ + (size_t)row * 384 + col) = w;
                        else if (col < 512) *(u32x2*)(LKV + (size_t)row * 128 + (col - 384)) = w;
                        else if (col < 544) *(f32x4*)(KR + (size_t)row * 32 + (col - 512)) = v; }
                float q0 = q[0], q1 = q[1];
                q0 += __shfl_xor(q0, 16); q0 += __shfl_xor(q0, 32); q1 += __shfl_xor(q1, 16); q1 += __shfl_xor(q1, 32);
                if (fq == 0) { if (u.pn == 0) SSL[(size_t)row * 16 + wc] = q0 + q1; else if (u.pn == 1) { SSL[(size_t)row * 16 + 4 + wc] = q0; SSL[(size_t)row * 16 + 8 + wc] = q1; } } }
    }
};

struct EpiSwiglu {
    static constexpr bool PERM = true, AFTER_DRAIN = false;
    bf16_t* H; RowScale rs;
    __device__ __forceinline__ void operator()(const f32x4 (&acc)[2][2][4][2], const Unit& u, int wr, int wc, int fr, int fq) const {
        const int row0 = u.pm * BM + wr * 64 + fr, col0 = u.pn * HALF + wc * 32 + 8 * fq;
#pragma unroll
        for (int ai = 0; ai < 2; ++ai)
#pragma unroll
            for (int m = 0; m < 4; ++m) { const int row = row0 + ai * HALF + m * 16; const float s = rs.get(row); bf16_t* rp = H + (size_t)row * FFH + col0; float h[8];
#pragma unroll
                for (int n = 0; n < 2; ++n) { const f32x4 g = acc[ai][0][m][n] * s, up = acc[ai][1][m][n] * s;
#pragma unroll
                    for (int j = 0; j < 4; ++j) h[4 * n + j] = g[j] * __builtin_amdgcn_rcpf(1.f + __builtin_amdgcn_exp2f(-g[j] * LOG2E)) * up[j]; }
                u32x4 w; w.x = cvt_pk_bf16(h[0], h[1]); w.y = cvt_pk_bf16(h[2], h[3]); w.z = cvt_pk_bf16(h[4], h[5]); w.w = cvt_pk_bf16(h[6], h[7]); __builtin_nontemporal_store(w, (u32x4*)rp); }
    }
};

template <bool PLEG> struct EpiResid {
    static constexpr bool PERM = false, AFTER_DRAIN = false;
    float* X; int row_int0; bf16_t* XBo; float* SSn; const bf16_t* PROJ; RowScale rs; float amul;
    __device__ __forceinline__ void operator()(const f32x4 (&acc)[2][2][4][2], const Unit& u, int wr, int wc, int fr, int fq) const {
        const int ext0 = ext_row(row_int0 + u.pm * BM); const int col0 = u.pn * BM + wc * 32 + 4 * fq;
#pragma unroll
        for (int ai = 0; ai < 2; ++ai)
#pragma unroll
            for (int m = 0; m < 4; ++m) { const int lrow = wr * 64 + fr + ai * HALF + m * 16, row = u.pm * BM + lrow; float* xp = X + (size_t)(ext0 + lrow) * DM + col0;
                const float s = PLEG ? rs.get(row) : 0.f; float q = 0.f;
#pragma unroll
                for (int bj = 0; bj < 2; ++bj)
#pragma unroll
                    for (int n = 0; n < 2; ++n) { const int off = bj * HALF + n * 16; const f32x4 xo = *(const f32x4*)(xp + off); const f32x4 a = acc[ai][bj][m][n]; f32x4 xn;
                        if (PLEG) { const u32x2 pw = *(const u32x2*)(PROJ + (size_t)row * DM + col0 + off); const float p[4] = {bf_lo(pw.x), bf_hi(pw.x), bf_lo(pw.y), bf_hi(pw.y)};
#pragma unroll
                            for (int j = 0; j < 4; ++j) xn[j] = xo[j] + __builtin_amdgcn_rcpf(1.f + __builtin_amdgcn_exp2f(-a[j] * s * LOG2E)) * p[j] * amul; }
                        else xn = xo + a * amul;
                        *(f32x4*)(xp + off) = xn; u32x2 w; w.x = cvt_pk_bf16(xn[0], xn[1]); w.y = cvt_pk_bf16(xn[2], xn[3]); *(u32x2*)(XBo + (size_t)row * DM + col0 + off) = w;
                        q += (xn[0] * xn[0] + xn[1] * xn[1]) + (xn[2] * xn[2] + xn[3] * xn[3]); }
                q += __shfl_xor(q, 16); q += __shfl_xor(q, 32);
                if (fq == 0) SSn[(size_t)row * 16 + u.pn * 4 + wc] = q; }
    }
};

template <class Epi, class Sched, bool ALIGN_EPI = false, bool SP2 = false>
__device__ __forceinline__ void gemm_phase(PG8_LAS unsigned char* lds, const Gemm g, const Sched& S, const Epi& E) {
    int tid_l = threadIdx.x; asm volatile("" : "+v"(tid_l));
    const int tid = tid_l, wid = __builtin_amdgcn_readfirstlane(tid >> 6), lane = tid & 63, wr = wid >> 2, wc = wid & 3, fr = lane & 15, fq = lane >> 4;
    const int K = g.K, nt = K / BK;
    unsigned voffA[2], voffB[2];
#pragma unroll
    for (int i = 0; i < 2; ++i) { int R, C; stage_rc(tid * 16 + i * 8192, R, C); const int Rb = Epi::PERM ? ((R & ~31) + perm32(R & 31)) : R;
        voffA[i] = (unsigned)(R * g.lda + C) * 2u; voffB[i] = (unsigned)(Rb * g.ldb + C) * 2u; }
    const size_t kstep = (size_t)(BK * 2);
    const size_t hstepA = (size_t)HALF * g.lda * 2, hstepB = (size_t)HALF * g.ldb * 2;
    const size_t tstepA = 2 * hstepA, tstepB = 2 * hstepB;
    const unsigned ldsw = (unsigned)wid * 1024u;
    const int aoff = lds_byte(wr * 64 + fr, fq * 8), boff = lds_byte(wc * 32 + fr, fq * 8);
#define PG8_SA(b, h) (((b) * 2 + (h)) * HTB)
#define PG8_SB(b, h) ((4 + (b) * 2 + (h)) * HTB)
#define PG8_STAGE(bufoff, gbase, voff) do { _Pragma("unroll") for (int _i = 0; _i < 2; ++_i) \
        __builtin_amdgcn_global_load_lds((const unsigned*)((const char*)(gbase) + (voff)[_i]), (PG8_LAS unsigned*)(lds + (bufoff) + ldsw + _i * 8192), 16, 0, 0); } while (0)
#define PG8_LDA(dst, b, h) do { _Pragma("unroll") for (int m = 0; m < 4; ++m) _Pragma("unroll") for (int k = 0; k < 2; ++k) dst[m][k] = *(const PG8_LAS bf16x8*)(lds + PG8_SA(b, h) + aoff + m * 2048 + k * 1024); } while (0)
#define PG8_LDB(dst, b, h) do { _Pragma("unroll") for (int n = 0; n < 2; ++n) _Pragma("unroll") for (int k = 0; k < 2; ++k) dst[n][k] = *(const PG8_LAS bf16x8*)(lds + PG8_SB(b, h) + boff + n * 2048 + k * 1024); } while (0)
#define PG8_MMA(ai, bj, At, Bt) do { __builtin_amdgcn_s_setprio(1); _Pragma("unroll") for (int m = 0; m < 4; ++m) _Pragma("unroll") for (int n = 0; n < 2; ++n) _Pragma("unroll") for (int k = 0; k < 2; ++k) \
        acc[ai][bj][m][n] = __builtin_amdgcn_mfma_f32_16x16x32_bf16(Bt[n][k], At[m][k], acc[ai][bj][m][n], 0, 0, 0); __builtin_amdgcn_s_setprio(0); } while (0)
#define PG8_WAIT_V(n) asm volatile("s_waitcnt vmcnt(" #n ")" ::: "memory")
#define PG8_WAIT_L(n) asm volatile("s_waitcnt lgkmcnt(" #n ")" ::: "memory")
#define PG8_BAR __builtin_amdgcn_s_barrier()
#define PG8_SCHED __builtin_amdgcn_sched_barrier(0)
    Unit cur, nxt; int ui = 0;
    if (!S.next(0, cur)) return;
    f32x4 acc[2][2][4][2];
#pragma unroll
    for (int a = 0; a < 2; ++a)
#pragma unroll
        for (int b = 0; b < 2; ++b)
#pragma unroll
            for (int m = 0; m < 4; ++m)
#pragma unroll
                for (int n = 0; n < 2; ++n) acc[a][b][m][n] = (f32x4){0.f, 0.f, 0.f, 0.f};
    bf16x8 At[4][2], B0[2][2], B1[2][2];
    const char* cA = (const char*)g.A + (size_t)cur.pm * tstepA; const char* cB = (const char*)g.Bt + (size_t)cur.pn * tstepB;
    S.a_ready(cur);
    if constexpr (SP2) {
        PG8_STAGE(PG8_SB(0, 0), cB, voffB); PG8_STAGE(PG8_SB(0, 1), cB + hstepB, voffB); PG8_STAGE(PG8_SA(0, 0), cA, voffA); PG8_STAGE(PG8_SA(0, 1), cA + hstepA, voffA);
        if (wr == 1) PG8_BAR;
        PG8_WAIT_V(2); PG8_BAR;
        PG8_STAGE(PG8_SB(1, 0), cB + kstep, voffB); PG8_STAGE(PG8_SA(1, 0), cA + kstep, voffA); PG8_STAGE(PG8_SB(1, 1), cB + hstepB + kstep, voffB);
        PG8_WAIT_V(6); PG8_BAR;
    } else {
        PG8_STAGE(PG8_SB(0, 0), cB, voffB); PG8_STAGE(PG8_SA(0, 0), cA, voffA); PG8_STAGE(PG8_SB(0, 1), cB + hstepB, voffB); PG8_STAGE(PG8_SA(0, 1), cA + hstepA, voffA);
        if (wr == 1) PG8_BAR;
        PG8_WAIT_V(4); PG8_BAR;
        PG8_STAGE(PG8_SB(1, 0), cB + kstep, voffB); PG8_STAGE(PG8_SA(1, 0), cA + kstep, voffA); PG8_STAGE(PG8_SB(1, 1), cB + hstepB + kstep, voffB);
        PG8_WAIT_V(6); PG8_BAR;
    }
    for (;;) {
        const bool has_next = S.next(ui + 1, nxt);
        const char* nA = has_next ? (const char*)g.A + (size_t)nxt.pm * tstepA : cA; const char* nB = has_next ? (const char*)g.Bt + (size_t)nxt.pn * tstepB : cB;
        for (int t = 0; t < nt; t += 2) {
            const bool last = (t == nt - 2);
            const char* a1 = cA + (size_t)(t + 1) * kstep;
            const char* a2 = last ? nA : cA + (size_t)(t + 2) * kstep; const char* b2 = last ? nB : cB + (size_t)(t + 2) * kstep;
            const char* a3 = a2 + kstep; const char* b3 = b2 + kstep;
            if (last && has_next) S.a_ready(nxt);
            if constexpr (SP2) {
            PG8_LDB(B0, 0, 0); PG8_LDB(B1, 0, 1); PG8_SCHED; PG8_LDA(At, 0, 0); PG8_STAGE(PG8_SA(1, 1), a1 + hstepA, voffA);
            PG8_WAIT_V(8); PG8_WAIT_L(0); PG8_BAR; PG8_MMA(0, 0, At, B0); PG8_MMA(0, 1, At, B1); PG8_BAR; PG8_SCHED;
            PG8_LDA(At, 0, 1); PG8_STAGE(PG8_SB(0, 0), b2, voffB); PG8_STAGE(PG8_SB(0, 1), b2 + hstepB, voffB); PG8_STAGE(PG8_SA(0, 0), a2, voffA);
            PG8_WAIT_V(8); PG8_WAIT_L(0); PG8_BAR; PG8_MMA(1, 0, At, B0); PG8_MMA(1, 1, At, B1); PG8_BAR; PG8_SCHED;
            PG8_LDB(B0, 1, 0); PG8_LDB(B1, 1, 1); PG8_SCHED; PG8_LDA(At, 1, 0); PG8_STAGE(PG8_SA(0, 1), a2 + hstepA, voffA);
            PG8_WAIT_V(8); PG8_WAIT_L(0); PG8_BAR; PG8_MMA(0, 0, At, B0); PG8_MMA(0, 1, At, B1); PG8_BAR; PG8_SCHED;
            PG8_LDA(At, 1, 1); PG8_STAGE(PG8_SB(1, 0), b3, voffB); PG8_STAGE(PG8_SB(1, 1), b3 + hstepB, voffB); PG8_STAGE(PG8_SA(1, 0), a3, voffA);
            PG8_WAIT_V(8); PG8_WAIT_L(0); PG8_BAR; PG8_MMA(1, 0, At, B0); PG8_MMA(1, 1, At, B1); PG8_BAR; PG8_SCHED;
            } else {
            PG8_LDB(B0, 0, 0); PG8_SCHED; PG8_LDA(At, 0, 0); PG8_STAGE(PG8_SA(1, 1), a1 + hstepA, voffA);
            PG8_WAIT_L(8); PG8_BAR; PG8_WAIT_L(0); PG8_MMA(0, 0, At, B0); PG8_BAR; PG8_SCHED;
            PG8_LDB(B1, 0, 1); PG8_STAGE(PG8_SB(0, 0), b2, voffB);
            PG8_BAR; PG8_WAIT_L(0); PG8_MMA(0, 1, At, B1); PG8_BAR;
            PG8_LDA(At, 0, 1); PG8_STAGE(PG8_SA(0, 0), a2, voffA);
            PG8_BAR; PG8_WAIT_L(0); PG8_MMA(1, 0, At, B0); PG8_BAR; PG8_SCHED;
            PG8_STAGE(PG8_SB(0, 1), b2 + hstepB, voffB);
            PG8_WAIT_V(6); PG8_BAR; PG8_MMA(1, 1, At, B1); PG8_BAR;
            PG8_LDB(B0, 1, 0); PG8_SCHED; PG8_LDA(At, 1, 0); PG8_STAGE(PG8_SA(0, 1), a2 + hstepA, voffA);
            PG8_WAIT_L(8); PG8_BAR; PG8_WAIT_L(0); PG8_MMA(0, 0, At, B0); PG8_BAR; PG8_SCHED;
            PG8_LDB(B1, 1, 1); PG8_STAGE(PG8_SB(1, 0), b3, voffB);
            PG8_BAR; PG8_WAIT_L(0); PG8_MMA(0, 1, At, B1); PG8_BAR;
            PG8_LDA(At, 1, 1); PG8_STAGE(PG8_SA(1, 0), a3, voffA);
            PG8_BAR; PG8_WAIT_L(0); PG8_MMA(1, 0, At, B0); PG8_BAR; PG8_SCHED;
            PG8_STAGE(PG8_SB(1, 1), b3 + hstepB, voffB);
            PG8_WAIT_V(6); PG8_BAR; PG8_MMA(1, 1, At, B1); PG8_BAR;
            }
        }
        if constexpr (ALIGN_EPI) { if (wr == 0) PG8_BAR; }
        if constexpr (!Epi::AFTER_DRAIN) { E(acc, cur, wr, wc, fr, fq); S.done(cur); }
        if (!has_next) break;
#pragma unroll
        for (int a = 0; a < 2; ++a)
#pragma unroll
            for (int b = 0; b < 2; ++b)
#pragma unroll
                for (int m = 0; m < 4; ++m)
#pragma unroll
                    for (int n = 0; n < 2; ++n) acc[a][b][m][n] = (f32x4){0.f, 0.f, 0.f, 0.f};
        cur = nxt; cA = nA; cB = nB; ++ui;
        if constexpr (ALIGN_EPI) { if (wr == 1) PG8_BAR; }
    }
    PG8_WAIT_V(0);
    if constexpr (!ALIGN_EPI) { if (wr == 0) PG8_BAR; }
    PG8_BAR;
    if constexpr (Epi::AFTER_DRAIN) { E.fused(acc, cur, wr, wc, fr, fq, lds, wid, lane); S.done(cur); }
#undef PG8_SA
#undef PG8_SB
#undef PG8_STAGE
#undef PG8_LDA
#undef PG8_LDB
#undef PG8_MMA
#undef PG8_WAIT_V
#undef PG8_WAIT_L
#undef PG8_BAR
#undef PG8_SCHED
}
}

#define LAS __attribute__((address_space(3)))
typedef unsigned short bf16_t;
using pg8::bf16x8; using pg8::f32x4; using pg8::u32x4; using pg8::u32x2; using pg8::cvt_pk_bf16; using pg8::bf_lo; using pg8::bf_hi;
typedef float f32x16 __attribute__((ext_vector_type(16)));
typedef float f32x2 __attribute__((ext_vector_type(2)));

#define XB_TMO      128
#define XB_XCNT(j)  (256  + 64 * (j))
#define XB_XSUB(j)  (1280 + 64 * (j))
#define XB_XGEN(j)  (2304 + 64 * (j))
#define XB_TOP      3328
#define XB_TOPGEN   3392
#define XCD_BAR_WORDS 3456
#define XB_SPIN_CAP (1u << 18)

__device__ __forceinline__ unsigned xb_ld(unsigned* p)              { return __hip_atomic_load(p, __ATOMIC_RELAXED, __HIP_MEMORY_SCOPE_AGENT); }
__device__ __forceinline__ unsigned xb_add(unsigned* p, unsigned v) { return __hip_atomic_fetch_add(p, v, __ATOMIC_RELAXED, __HIP_MEMORY_SCOPE_AGENT); }
__device__ __forceinline__ unsigned xb_xcc_id() { return (unsigned)__builtin_amdgcn_s_getreg((3 << 11) | 20) & 0xFu; }
#define XB_SPIN(cond, bar) do { unsigned _sp = 0; while (cond) { __builtin_amdgcn_s_sleep(1); \
    if ((++_sp & 255u) == 0u) { if (xb_ld(&(bar)[XB_TMO])) break; if (_sp > XB_SPIN_CAP) { atomicAdd(&(bar)[XB_TMO], 1u); break; } } } } while (0)

struct XcdBarrier {
    unsigned* bar; unsigned x;
    volatile LAS unsigned* st;
};

__device__ __forceinline__ XcdBarrier xcd_barrier_post(unsigned* bar, volatile LAS unsigned* st) {
    XcdBarrier b; b.bar = bar; b.x = xb_xcc_id(); b.st = st;
    if (threadIdx.x == 0) (void)xb_add(&bar[XB_XCNT(b.x)], 1u);
    return b;
}
__device__ __forceinline__ void xcd_barrier_complete(unsigned* bar, unsigned x, unsigned& nloc, unsigned& nx) {
    const unsigned G = gridDim.x * gridDim.y * gridDim.z;
    unsigned sum, cnt, mine, sp = 0u;
    for (;;) {
        sum = 0u; cnt = 0u; mine = 0u;
#pragma unroll
        for (unsigned j = 0; j < 16; ++j) { const unsigned c = xb_ld(&bar[XB_XCNT(j)]); sum += c; cnt += (c > 0u) ? 1u : 0u; mine = (j == x) ? c : mine; }
        if (sum == G) break;
        __builtin_amdgcn_s_sleep(1);
        if ((++sp & 255u) == 0u) { if (xb_ld(&bar[XB_TMO])) break; if (sp > XB_SPIN_CAP) { atomicAdd(&bar[XB_TMO], 1u); break; } }
    }
    nloc = mine > 0u ? mine : 1u; nx = cnt > 0u ? cnt : 1u;
}

__device__ __forceinline__ void xcd_barrier(const XcdBarrier& b) {
    asm volatile("s_waitcnt vmcnt(0)" ::: "memory");
    __syncthreads();
    if (threadIdx.x == 0) {
        unsigned* bar = b.bar;
        __builtin_amdgcn_s_waitcnt(0);
        unsigned nloc = b.st[0], nx = b.st[1];
        if (nloc == 0u) { xcd_barrier_complete(bar, b.x, nloc, nx); b.st[0] = nloc; b.st[1] = nx; }
        const unsigned old = xb_add(&bar[XB_XSUB(b.x)], 1u);
        const unsigned gen = old / nloc;
        if (old + 1u == (gen + 1u) * nloc) {
            __builtin_amdgcn_fence(__ATOMIC_RELEASE, "agent");
            asm volatile("s_waitcnt vmcnt(0)" ::: "memory");
            const unsigned og = xb_add(&bar[XB_TOP], 1u);
            const unsigned tg = og / nx;
            if (og + 1u == (tg + 1u) * nx) xb_add(&bar[XB_TOPGEN], 1u);
            else XB_SPIN(xb_ld(&bar[XB_TOPGEN]) == tg, bar);
            __builtin_amdgcn_fence(__ATOMIC_ACQUIRE, "agent");
            xb_add(&bar[XB_XGEN(b.x)], 1u);
            asm volatile("s_waitcnt vmcnt(0)" ::: "memory");
        } else {
            XB_SPIN(xb_ld(&bar[XB_XGEN(b.x)]) == gen, bar);
            __builtin_amdgcn_fence(__ATOMIC_ACQUIRE, "agent");
            asm volatile("s_waitcnt vmcnt(0)" ::: "memory");
        }
    }
    __syncthreads();
}

constexpr size_t MiB = 1u << 20;
constexpr size_t WS_ROPE = 0;
constexpr size_t WS_WL = 1 * MiB;
constexpr size_t WS_XB = 26 * MiB;
constexpr size_t WS_SS0 = 218 * MiB, WS_SS1 = 224 * MiB, WS_SSL = 230 * MiB;
constexpr size_t WS_PB = 236 * MiB;
constexpr size_t WS_TR = 284 * MiB;
constexpr size_t WS_XB2 = WS_TR;
constexpr size_t WS_H = WS_TR;
constexpr size_t WS_PROJ = 812 * MiB;
constexpr size_t WS_QKV = 476 * MiB;
constexpr size_t WS_VTA = 764 * MiB;
constexpr size_t WS_LQ = 476 * MiB, WS_LKV = 548 * MiB, WS_KR = 572 * MiB;
constexpr size_t WS_Q = WS_TR;
constexpr size_t WS_KV = 584 * MiB;
constexpr size_t WS_K = 776 * MiB;
constexpr size_t WS_VTB = 920 * MiB;
constexpr size_t WS_END = 1016 * MiB;
constexpr size_t WS_BAR = WS_END, WS_BAR_BYTES = 16384, WS_TOTAL = WS_BAR + WS_BAR_BYTES;
static_assert(XCD_BAR_WORDS * 4 <= WS_BAR_BYTES, "barrier words");
static_assert(WS_H + (size_t)TT * FFH * 2 <= WS_PROJ && WS_PROJ + (size_t)TT * DM * 2 <= WS_END, "ffn map");
static_assert(WS_XB2 + (size_t)TT * DM * 2 <= WS_QKV && WS_QKV + (size_t)TT * 1536 * 2 <= WS_VTA && WS_VTA + (size_t)TT * 256 * 2 <= WS_PROJ, "mixer A map");
static_assert(WS_LQ + (size_t)TT * 384 * 2 <= WS_LKV && WS_LKV + (size_t)TT * 128 * 2 <= WS_KR && WS_KR + (size_t)TT * 32 * 4 <= WS_KV, "mixer B map 1");
static_assert(WS_Q + (size_t)TH * 1536 * 2 <= WS_LQ && WS_KV + (size_t)TH * 2048 * 2 <= WS_K && WS_K + (size_t)TH * 1536 * 2 <= WS_VTB && WS_VTB + (size_t)TH * 1024 * 2 <= WS_END, "mixer B map 2");
static_assert(WS_XB + (size_t)TT * DM * 2 <= WS_SS0 && WS_PB + (size_t)TT * PLE * 2 <= WS_TR, "fixed map");
constexpr size_t WE = 1u << 20;
constexpr size_t WO_MIX = 0, WO_MIX_O_A = WE * 3 / 2;
constexpr size_t WO_B_UQ = WE * 3 / 4, WO_B_UKV = WE * 21 / 16, WO_B_O = WE * 25 / 16;
constexpr size_t WO_GU = 3 * WE, WO_D = WE * 17 / 2, WO_PG = WE * 45 / 4, WO_PP = WE * 49 / 4, WO_END = WE * 25 / 2;
static_assert(WO_B_UQ == 768u * 1024 && WO_B_UKV == WO_B_UQ + 1536u * 384 && WO_B_O == WO_B_UKV + 2048u * 128 && WO_B_O + WE <= WO_GU, "weight map B");
static_assert(WO_D == WO_GU + 5632u * 1024 && WO_PG == WO_D + 1024u * 2816 && WO_PP == WO_PG + WE && WO_END == WO_PP + 1024u * 256 && WO_END * 2 <= 25 * MiB, "weight map");

constexpr int LDS_BYTES = 131072 + 1024;
__constant__ float INV_FREQ[16] = {1.000000000e+00f, 4.403666258e-01f, 1.939227581e-01f, 8.539710194e-02f, 3.760603070e-02f, 1.656044088e-02f, 7.292665076e-03f, 3.211446106e-03f,
                                   1.414213446e-03f, 6.227724371e-04f, 2.742481884e-04f, 1.207697424e-04f, 5.318296462e-05f, 2.341999789e-05f, 1.031338525e-05f, 4.541670478e-06f};

__device__ __forceinline__ float wave_sum(float v) {
#pragma unroll
    for (int o = 1; o < 64; o <<= 1) v += __shfl_xor(v, o);
    return v;
}
__device__ __forceinline__ void unpack8(const u32x4 w, float* v) { v[0] = bf_lo(w.x); v[1] = bf_hi(w.x); v[2] = bf_lo(w.y); v[3] = bf_hi(w.y); v[4] = bf_lo(w.z); v[5] = bf_hi(w.z); v[6] = bf_lo(w.w); v[7] = bf_hi(w.w); }
__device__ __forceinline__ u32x4 pack8(const float* v) { u32x4 w; w.x = cvt_pk_bf16(v[0], v[1]); w.y = cvt_pk_bf16(v[2], v[3]); w.z = cvt_pk_bf16(v[4], v[5]); w.w = cvt_pk_bf16(v[6], v[7]); return w; }

__device__ __forceinline__ void cvt_item(const float* W, int K, int Nsrc, int Ndst, int mode, const float* gain, bf16_t* dst, LAS float* scr, int it, int lane) {
    const int nblk = Ndst / 32;
    const int kb = it / nblk, nb = it % nblk, k0 = 64 * kb, n0 = 32 * nb;
    int src0;
    if (mode == 1) { const int tile = nb >> 3, w = nb & 7; src0 = (w >> 2) * FFH + tile * 128 + (w & 3) * 32; }
    else src0 = (n0 < Nsrc) ? n0 : -1;
#pragma unroll 8
    for (int i = 0; i < 32; ++i) { const int kk = 2 * i + (lane >> 5); float v = src0 >= 0 ? W[(size_t)(k0 + kk) * Nsrc + src0 + (lane & 31)] : 0.f; if (gain) v *= gain[k0 + kk]; scr[kk * 33 + (lane & 31)] = v; }
    asm volatile("s_waitcnt lgkmcnt(0)" ::: "memory");
    const int c = lane & 7;
#pragma unroll
    for (int j = 0; j < 4; ++j) { const int n = (lane >> 3) + 8 * j; const LAS float* s = scr + (8 * c) * 33 + n;
        u32x4 o; o.x = cvt_pk_bf16(s[0 * 33], s[1 * 33]); o.y = cvt_pk_bf16(s[2 * 33], s[3 * 33]); o.z = cvt_pk_bf16(s[4 * 33], s[5 * 33]); o.w = cvt_pk_bf16(s[6 * 33], s[7 * 33]);
        *(u32x4*)(dst + (size_t)(n0 + n) * K + k0 + 8 * c) = o; }
    asm volatile("s_waitcnt lgkmcnt(0)" ::: "memory");
}
struct Args { const float* in[24]; float* out; unsigned char* ws; int ph_lo, ph_hi; };
__device__ __forceinline__ void cvt_layer(const Args& a, int L, bf16_t* WLp, LAS float* scr, int gw, int NGW, int part  ) {
    int tl = threadIdx.x; asm volatile("" : "+v"(tl)); const int lane = tl & 63;
    const int j = L >> 1; const bool isA = (L & 1) == 0;
    const int n0 = isA ? 768 : 384, n1 = isA ? 512 : 288, n2 = isA ? 0 : 128, n3 = isA ? 0 : 512;
    const int total = n0 + n1 + n2 + n3 + 2816 + 1408 + 512 + 128;
    const int nm = n0 + n1 + n2 + n3; const int it_lo = (part & 1) ? 0 : ((part & 2) ? nm : nm + 4224), it_hi = (part & 4) ? total : ((part & 2) ? nm + 4224 : nm);
    for (int it = it_lo + gw; it < it_hi; it += NGW) {
        int r = it; const float* W; int K, Nsrc, Ndst, mode = 0; const float* gain = nullptr; size_t doff;
        if (r < n0) { if (isA) { W = a.in[5] + (size_t)j * 1024 * 1536; K = 1024; Nsrc = 1536; Ndst = 1536; } else { W = a.in[10] + (size_t)j * 1024 * 544; K = 1024; Nsrc = 544; Ndst = 768; } gain = a.in[4] + L * 1024; doff = WO_MIX; }
        else if ((r -= n0) < n1) { if (isA) { W = a.in[9] + (size_t)j * 1024 * 1024; K = 1024; Nsrc = 1024; Ndst = 1024; doff = WO_MIX_O_A; } else { W = a.in[13] + (size_t)j * 384 * 1536; K = 384; Nsrc = 1536; Ndst = 1536; gain = a.in[11] + j * 384; doff = WO_B_UQ; } }
        else if ((r -= n1) < n2) { W = a.in[14] + (size_t)j * 128 * 2048; K = 128; Nsrc = 2048; Ndst = 2048; gain = a.in[12] + j * 128; doff = WO_B_UKV; }
        else if ((r -= n2) < n3) { W = a.in[17] + (size_t)j * 1024 * 1024; K = 1024; Nsrc = 1024; Ndst = 1024; doff = WO_B_O; }
        else if ((r -= n3) < 2816) { W = a.in[19] + (size_t)L * 1024 * 5632; K = 1024; Nsrc = 5632; Ndst = 5632; mode = 1; gain = a.in[18] + L * 1024; doff = WO_GU; }
        else if ((r -= 2816) < 1408) { W = a.in[20] + (size_t)L * 2816 * 1024; K = 2816; Nsrc = 1024; Ndst = 1024; doff = WO_D; }
        else if ((r -= 1408) < 512) { W = a.in[22] + (size_t)L * 1024 * 1024; K = 1024; Nsrc = 1024; Ndst = 1024; gain = a.in[21] + L * 1024; doff = WO_PG; }
        else { r -= 512; W = a.in[23] + (size_t)L * 256 * 1024; K = 256; Nsrc = 1024; Ndst = 1024; doff = WO_PP; }
        cvt_item(W, K, Nsrc, Ndst, mode, gain, WLp + doff, scr, r, lane);
    }
}

__device__ __forceinline__ int crow(int r, int hi) { return (r & 3) + 8 * (r >> 2) + 4 * hi; }
typedef float f32x2_t __attribute__((ext_vector_type(2))); typedef __bf16 bf16x2_t __attribute__((ext_vector_type(2)));
__device__ __forceinline__ float max3f(float a, float b, float c) { float r; asm("v_max3_f32 %0, %1, %2, %3" : "=v"(r) : "v"(a), "v"(b), "v"(c)); return r; }
__device__ __forceinline__ unsigned cvtpk_s(float lo, float hi) { f32x2_t v = {lo, hi}; bf16x2_t b = __builtin_convertvector(v, bf16x2_t); return __builtin_bit_cast(unsigned, b); }
template <int DQK, bool WIN>
__device__ __forceinline__ void attn_unit(LAS unsigned char* lds, const bf16_t* qrow, bf16_t* orow, const bf16_t* Kb, int ldk, const bf16_t* Vtb, int ldv,
                                          int kt0, int kt1, int qpos, float m_init, float l_init) {
    constexpr int KP = DQK + 8, VP = 72, KBUF = 64 * KP * 2, VBUF = 64 * VP * 2, CPR = DQK / 8, NCH = 64 * CPR, ND = DQK / 16;
    constexpr float THR = 8.f;
    int tid_l = threadIdx.x; asm volatile("" : "+v"(tid_l));
    const int tid = tid_l, lane = tid & 63, r32 = lane & 31, hi = lane >> 5;
    LAS unsigned char* Kl = lds; LAS unsigned char* Vl = lds + 2 * KBUF;
    bf16x8 qf[ND];
#pragma unroll
    for (int d0 = 0; d0 < ND; ++d0) qf[d0] = *(const bf16x8*)(qrow + d0 * 16 + hi * 8);
    f32x16 o0, o1, negm;
#pragma unroll
    for (int r = 0; r < 16; ++r) { o0[r] = 0.f; o1[r] = 0.f; negm[r] = -m_init; }
    float m = m_init, l = hi == 0 ? l_init : 0.f;
    u32x4 kxa0, kxa1, vxa, kxb0, kxb1, vxb;
    const int c1 = (tid + 512) < NCH ? tid + 512 : tid;
    const int kr0 = tid / CPR, kc0 = tid % CPR, kr1 = c1 / CPR, kc1 = c1 % CPR;
    const int vd = tid >> 3, vcc = tid & 7;
    const int n = kt1 - kt0;
#define ATT_LOADK(K0_, K1_, t) do { K0_ = *(const u32x4*)(Kb + (size_t)(64 * (t) + kr0) * ldk + kc0 * 8); if (NCH > 512) K1_ = *(const u32x4*)(Kb + (size_t)(64 * (t) + kr1) * ldk + kc1 * 8); } while (0)
#define ATT_LOADV(V_, t) do { V_ = *(const u32x4*)(Vtb + (size_t)vd * ldv + 64 * (t) + vcc * 8); } while (0)
#define ATT_STOREK(K0_, K1_, b) do { *(LAS u32x4*)(Kl + (b) * KBUF + kr0 * (KP * 2) + kc0 * 16) = K0_; if (NCH > 512) *(LAS u32x4*)(Kl + (b) * KBUF + kr1 * (KP * 2) + kc1 * 16) = K1_; } while (0)
#define ATT_STOREV(V_, b) do { *(LAS u32x4*)(Vl + (b) * VBUF + vd * (VP * 2) + vcc * 16) = V_; } while (0)
#define ATT_BAR() do { asm volatile("s_waitcnt lgkmcnt(0)" ::: "memory"); __builtin_amdgcn_s_barrier(); asm volatile("" ::: "memory"); } while (0)
#define ATT_QK(S0, S1, b) do { const LAS unsigned char* kp_ = Kl + (b) * KBUF + r32 * (KP * 2) + hi * 16; \
        _Pragma("unroll") for (int d0 = 0; d0 < ND; ++d0) { const bf16x8 k0_ = *(const LAS bf16x8*)(kp_ + d0 * 32); const bf16x8 k1_ = *(const LAS bf16x8*)(kp_ + 32 * KP * 2 + d0 * 32); \
            if (d0 == 0) { S0 = __builtin_amdgcn_mfma_f32_32x32x16_bf16(k0_, qf[0], negm, 0, 0, 0); S1 = __builtin_amdgcn_mfma_f32_32x32x16_bf16(k1_, qf[0], negm, 0, 0, 0); } \
            else { S0 = __builtin_amdgcn_mfma_f32_32x32x16_bf16(k0_, qf[d0], S0, 0, 0, 0); S1 = __builtin_amdgcn_mfma_f32_32x32x16_bf16(k1_, qf[d0], S1, 0, 0, 0); } } } while (0)
#define SB_() __builtin_amdgcn_sched_barrier(0)
#define ATT_MAXP(S0, S1, MXV) do { float mx2_ = __builtin_fmaxf(S0[0], S1[0]); \
        _Pragma("unroll") for (int r = 1; r < 16; ++r) mx2_ = __builtin_fmaxf(mx2_, __builtin_fmaxf(S0[r], S1[r])); MXV = mx2_; } while (0)
#define ATT_EXP(idx_, C0, C1) do { if ((idx_) < 16) { C0[(idx_) & 15] = __builtin_amdgcn_exp2f(C0[(idx_) & 15]); ls_ += C0[(idx_) & 15]; } else { C1[(idx_) & 15] = __builtin_amdgcn_exp2f(C1[(idx_) & 15]); ls_ += C1[(idx_) & 15]; } } while (0)
#define ATT_STEP(i_, C0, C1, N0, N1, LK0, LK1, LV, SK0, SK1, SV) do { const int ii_ = (i_); const int b_ = ii_ & 1; constexpr int NG_ = 2 * ND, EQ_ = 24 / NG_; \
        { const int tk_ = (kt0 + ii_ + 3) < kt1 ? (kt0 + ii_ + 3) : (kt1 - 1), tv_ = (kt0 + ii_ + 2) < kt1 ? (kt0 + ii_ + 2) : (kt1 - 1); ATT_LOADK(LK0, LK1, tk_); ATT_LOADV(LV, tv_); } \
        bf16x8 kf_[NG_]; \
        { const LAS unsigned char* kp_ = Kl + (b_ ^ 1) * KBUF + r32 * (KP * 2) + hi * 16; \
          _Pragma("unroll") for (int g = 0; g < ND; ++g) kf_[g] = *(const LAS bf16x8*)(kp_ + (g & 1) * (32 * KP * 2) + (g >> 1) * 32); } \
        SB_(); \
        if (WIN) { const int kb_ = 64 * (kt0 + ii_) + 4 * hi - qpos; \
            _Pragma("unroll") for (int r = 0; r < 16; ++r) { const int dk_ = kb_ + (r & 3) + 8 * (r >> 2); if (dk_ > 128 || dk_ < -128) C0[r] = -1e30f; if (dk_ + 32 > 128 || dk_ + 32 < -128) C1[r] = -1e30f; } \
            ATT_MAXP(C0, C1, mxc); } \
        float mx_; { auto rr_ = __builtin_amdgcn_permlane32_swap(__float_as_uint(mxc), __float_as_uint(mxc), false, false); mx_ = fmaxf(__uint_as_float(rr_[0]), __uint_as_float(rr_[1])); } \
        const bool first_ = !WIN && ii_ == 0; \
        if (first_ || __any(mx_ > THR)) { const float d_ = first_ ? mx_ : fmaxf(mx_, 0.f); m += d_; const float al_ = __builtin_amdgcn_exp2f(-d_); l *= al_; \
            _Pragma("unroll") for (int r = 0; r < 16; ++r) { C0[r] -= d_; C1[r] -= d_; o0[r] *= al_; o1[r] *= al_; negm[r] = -m; } } \
        SB_(); \
        float ls_ = 0.f; bf16x8 vf_[8]; \
        const LAS unsigned char* vp_ = Vl + b_ * VBUF + r32 * (VP * 2) + hi * 16; \
        _Pragma("unroll") for (int g = 0; g < NG_; ++g) { \
            if ((g & 1) == 0) { if (g == 0) N0 = __builtin_amdgcn_mfma_f32_32x32x16_bf16(kf_[0], qf[0], negm, 0, 0, 0); else N0 = __builtin_amdgcn_mfma_f32_32x32x16_bf16(kf_[g], qf[g >> 1], N0, 0, 0, 0); } \
            else { if (g == 1) N1 = __builtin_amdgcn_mfma_f32_32x32x16_bf16(kf_[1], qf[0], negm, 0, 0, 0); else N1 = __builtin_amdgcn_mfma_f32_32x32x16_bf16(kf_[g], qf[g >> 1], N1, 0, 0, 0); } \
            if (g < ND) { const LAS unsigned char* kp_ = Kl + (b_ ^ 1) * KBUF + r32 * (KP * 2) + hi * 16; kf_[g + ND] = *(const LAS bf16x8*)(kp_ + ((g + ND) & 1) * (32 * KP * 2) + ((g + ND) >> 1) * 32); } \
            if (g >= NG_ - 4) { const int f = g - (NG_ - 4); vf_[f] = *(const LAS bf16x8*)(vp_ + (f & 1) * (32 * VP * 2) + (f >> 1) * 32); } \
            _Pragma("unroll") for (int e = 0; e < EQ_; ++e) ATT_EXP(g * EQ_ + e, C0, C1); \
            SB_(); } \
        u32x4 pw_[4]; \
        pw_[0].x = cvtpk_s(C0[0], C0[1]); pw_[0].y = cvtpk_s(C0[2], C0[3]); pw_[0].z = cvtpk_s(C0[4], C0[5]); pw_[0].w = cvtpk_s(C0[6], C0[7]); \
        SB_(); \
        float mxa_ = 0.f, mxb_ = 0.f; \
        o0 = __builtin_amdgcn_mfma_f32_32x32x16_bf16(vf_[0], __builtin_bit_cast(bf16x8, pw_[0]), o0, 0, 0, 0); \
        pw_[1].x = cvtpk_s(C0[8], C0[9]); pw_[1].y = cvtpk_s(C0[10], C0[11]); ATT_EXP(24, C0, C1); ATT_EXP(25, C0, C1); \
        vf_[4] = *(const LAS bf16x8*)(vp_ + 64); vf_[5] = *(const LAS bf16x8*)(vp_ + (32 * VP * 2) + 64); \
        SB_(); \
        o1 = __builtin_amdgcn_mfma_f32_32x32x16_bf16(vf_[1], __builtin_bit_cast(bf16x8, pw_[0]), o1, 0, 0, 0); \
        pw_[1].z = cvtpk_s(C0[12], C0[13]); pw_[1].w = cvtpk_s(C0[14], C0[15]); ATT_EXP(26, C0, C1); ATT_EXP(27, C0, C1); \
        vf_[6] = *(const LAS bf16x8*)(vp_ + 96); vf_[7] = *(const LAS bf16x8*)(vp_ + (32 * VP * 2) + 96); \
        SB_(); \
        o0 = __builtin_amdgcn_mfma_f32_32x32x16_bf16(vf_[2], __builtin_bit_cast(bf16x8, pw_[1]), o0, 0, 0, 0); \
        pw_[2].x = cvtpk_s(C1[0], C1[1]); pw_[2].y = cvtpk_s(C1[2], C1[3]); ATT_EXP(28, C0, C1); ATT_EXP(29, C0, C1); \
        SB_(); \
        o1 = __builtin_amdgcn_mfma_f32_32x32x16_bf16(vf_[3], __builtin_bit_cast(bf16x8, pw_[1]), o1, 0, 0, 0); \
        pw_[2].z = cvtpk_s(C1[4], C1[5]); pw_[2].w = cvtpk_s(C1[6], C1[7]); ATT_EXP(30, C0, C1); ATT_EXP(31, C0, C1); \
        SB_(); \
        o0 = __builtin_amdgcn_mfma_f32_32x32x16_bf16(vf_[4], __builtin_bit_cast(bf16x8, pw_[2]), o0, 0, 0, 0); \
        pw_[3].x = cvtpk_s(C1[8], C1[9]); pw_[3].y = cvtpk_s(C1[10], C1[11]); \
        if (!WIN) { mxa_ = max3f(N0[0], N1[0], N0[1]); mxb_ = max3f(N1[1], N0[2], N1[2]); mxa_ = max3f(mxa_, N0[3], N1[3]); mxb_ = max3f(mxb_, N0[4], N1[4]); } \
        SB_(); \
        o1 = __builtin_amdgcn_mfma_f32_32x32x16_bf16(vf_[5], __builtin_bit_cast(bf16x8, pw_[2]), o1, 0, 0, 0); \
        pw_[3].z = cvtpk_s(C1[12], C1[13]); pw_[3].w = cvtpk_s(C1[14], C1[15]); \
        if (!WIN) { mxa_ = max3f(mxa_, N0[5], N1[5]); mxb_ = max3f(mxb_, N0[6], N1[6]); mxa_ = max3f(mxa_, N0[7], N1[7]); mxb_ = max3f(mxb_, N0[8], N1[8]); } \
        SB_(); \
        o0 = __builtin_amdgcn_mfma_f32_32x32x16_bf16(vf_[6], __builtin_bit_cast(bf16x8, pw_[3]), o0, 0, 0, 0); \
        if (!WIN) { mxa_ = max3f(mxa_, N0[9], N1[9]); mxb_ = max3f(mxb_, N0[10], N1[10]); mxa_ = max3f(mxa_, N0[11], N1[11]); mxb_ = max3f(mxb_, N0[12], N1[12]); } \
        SB_(); \
        o1 = __builtin_amdgcn_mfma_f32_32x32x16_bf16(vf_[7], __builtin_bit_cast(bf16x8, pw_[3]), o1, 0, 0, 0); \
        if (!WIN) { mxa_ = max3f(mxa_, N0[13], N1[13]); mxb_ = max3f(mxb_, N0[14], N1[14]); mxa_ = max3f(mxa_, N0[15], N1[15]); mxc = fmaxf(mxa_, mxb_); } \
        l += ls_; \
        SB_(); \
        ATT_STOREV(SV, b_ ^ 1); ATT_STOREK(SK0, SK1, b_); \
        ATT_BAR(); } while (0)
    ATT_LOADK(kxa0, kxa1, kt0); ATT_LOADV(vxa, kt0); ATT_STOREK(kxa0, kxa1, 0); ATT_STOREV(vxa, 0);
    { const int t1_ = (kt0 + 1) < kt1 ? (kt0 + 1) : (kt1 - 1); ATT_LOADK(kxa0, kxa1, t1_); ATT_STOREK(kxa0, kxa1, 1); }
    { const int t2_ = (kt0 + 2) < kt1 ? (kt0 + 2) : (kt1 - 1), t1_ = (kt0 + 1) < kt1 ? (kt0 + 1) : (kt1 - 1); ATT_LOADK(kxb0, kxb1, t2_); ATT_LOADV(vxb, t1_); }
    ATT_BAR();
    f32x16 sa0, sa1, sb0, sb1; float mxc = 0.f;
    ATT_QK(sa0, sa1, 0);
    if (!WIN) ATT_MAXP(sa0, sa1, mxc);
    ATT_BAR();
    int it = 0;
    for (; it + 1 < n; it += 2) { ATT_STEP(it, sa0, sa1, sb0, sb1, kxa0, kxa1, vxa, kxb0, kxb1, vxb); ATT_STEP(it + 1, sb0, sb1, sa0, sa1, kxb0, kxb1, vxb, kxa0, kxa1, vxa); }
    if (it < n) ATT_STEP(it, sa0, sa1, sb0, sb1, kxa0, kxa1, vxa, kxb0, kxb1, vxb);
    asm volatile("s_waitcnt vmcnt(0)" ::: "memory");
#undef ATT_LOADK
#undef ATT_LOADV
#undef ATT_STOREK
#undef ATT_STOREV
#undef ATT_QK
#undef ATT_STEP
#undef ATT_MAXP
#undef ATT_EXP
#undef SB_
#undef ATT_BAR
    l += __shfl_xor(l, 32); const float rl = 1.f / l;
#pragma unroll
    for (int g = 0; g < 4; ++g) { u32x2 w; w.x = cvt_pk_bf16(o0[4 * g] * rl, o0[4 * g + 1] * rl); w.y = cvt_pk_bf16(o0[4 * g + 2] * rl, o0[4 * g + 3] * rl); *(u32x2*)(orow + 8 * g + 4 * hi) = w;
        w.x = cvt_pk_bf16(o1[4 * g] * rl, o1[4 * g + 1] * rl); w.y = cvt_pk_bf16(o1[4 * g + 2] * rl, o1[4 * g + 3] * rl); *(u32x2*)(orow + 32 + 8 * g + 4 * hi) = w; }
}

__device__ __forceinline__ void pb_chunk(const float* pp, const float* ps, int layer, bf16_t* PB, int tok0, int tid) {
    f32x4 v[8];
#pragma unroll
    for (int k = 0; k < 8; ++k) { const int idx4 = tid + 512 * k, tok = tok0 + (idx4 >> 6), c4 = idx4 & 63; const int e = ext_row(tok);
        const float* src = e < 65536 ? pp + ((size_t)layer * 65536 + e) * PLE : ps + ((size_t)layer * 32768 + (e - 65536)) * PLE;
        v[k] = *(const f32x4*)(src + c4 * 4); }
#pragma unroll
    for (int k = 0; k < 8; ++k) { const int idx4 = tid + 512 * k, tok = tok0 + (idx4 >> 6), c4 = idx4 & 63;
        u32x2 w; w.x = cvt_pk_bf16(v[k][0], v[k][1]); w.y = cvt_pk_bf16(v[k][2], v[k][3]); *(u32x2*)(PB + (size_t)tok * PLE + c4 * 4) = w; }
}
__device__ __forceinline__ void fixup_a(LAS unsigned char* lds, bf16_t* QKV, bf16_t* VtA, const float* qg, const float* kg, const f32x2* rope, int vcu, int G,
                                        const float* pp, const float* ps, int layer, bf16_t* PB) {
    int tid_l = threadIdx.x; asm volatile("" : "+v"(tid_l));
    const int tid = tid_l, lane = tid & 63, wid = tid >> 6, sub = lane & 7, hl = lane >> 3;
    LAS bf16_t* vt = (LAS bf16_t*)lds;
    for (int chunk = vcu; chunk < TT / 64; chunk += G) {
        const int tok0 = chunk * 64; int st, S; seq_of(tok0, st, S);
        for (int ib = 0; ib < 2; ++ib) {
            u32x4 rawb[4][3]; f32x2 csb[4][8];
#pragma unroll
            for (int t = 0; t < 4; ++t) { const int tok = tok0 + wid * 8 + ib * 4 + t, pos = tok - st; const bf16_t* rowp = QKV + (size_t)tok * 1536;
#pragma unroll
                for (int rr = 0; rr < 3; ++rr) rawb[t][rr] = *(const u32x4*)(rowp + (rr * 8 + hl) * 64 + sub * 8);
#pragma unroll
                for (int e = 0; e < 8; ++e) csb[t][e] = rope[pos * 16 + 2 * e]; }
#pragma unroll
            for (int t = 0; t < 4; ++t) { const int i = ib * 4 + t; const int tok = tok0 + wid * 8 + i; bf16_t* rowp = QKV + (size_t)tok * 1536;
#pragma unroll
                for (int rr = 0; rr < 3; ++rr) { const int hh = rr * 8 + hl; const u32x4 raw = rawb[t][rr];
                    float v[8]; unpack8(raw, v);
                    float ss = 0.f;
#pragma unroll
                    for (int e = 0; e < 8; ++e) ss += v[e] * v[e];
                    ss += __shfl_xor(ss, 1); ss += __shfl_xor(ss, 2); ss += __shfl_xor(ss, 4);
                    const float rs = __builtin_amdgcn_rsqf(ss * (1.f / 64.f) + EPS);
                    const float* g = hh < 16 ? qg : kg;
                    float pv[8];
#pragma unroll
                    for (int e = 0; e < 8; ++e) { v[e] = v[e] * rs * g[sub * 8 + e]; pv[e] = __shfl_xor(v[e], 1); }
                    if (sub < 2) {
#pragma unroll
                        for (int e = 0; e < 8; ++e) { const f32x2 cs = csb[t][e]; v[e] = sub == 0 ? v[e] * cs.x - pv[e] * cs.y : pv[e] * cs.y + v[e] * cs.x; } }
                    if (hh < 16) {
#pragma unroll
                        for (int e = 0; e < 8; ++e) v[e] *= 0.125f * LOG2E; }
                    if (hh < 20) *(u32x4*)(rowp + hh * 64 + sub * 8) = pack8(v);
                    else { const int hv = hh - 20; const unsigned w[4] = {raw.x, raw.y, raw.z, raw.w};
#pragma unroll
                        for (int e = 0; e < 8; ++e) vt[(hv * 64 + sub * 8 + e) * 72 + wid * 8 + i] = (bf16_t)((e & 1) ? (w[e >> 1] >> 16) : (w[e >> 1] & 0xffffu)); } } } }
        __syncthreads();
#pragma unroll
        for (int k = 0; k < 4; ++k) { const int c = tid + 512 * k, row = c >> 3, cc = c & 7, hv = row >> 6, d = row & 63;
            const u32x2 d0_ = *(const LAS u32x2*)(vt + row * 72 + (cc >> 1) * 16 + (cc & 1) * 4), d1_ = *(const LAS u32x2*)(vt + row * 72 + (cc >> 1) * 16 + 8 + (cc & 1) * 4);
            u32x4 dat; dat.x = d0_.x; dat.y = d0_.y; dat.z = d1_.x; dat.w = d1_.y;
            *(u32x4*)(VtA + (size_t)st * 256 + (size_t)hv * 64 * S + (size_t)d * S + (tok0 - st) + cc * 8) = dat; }
        pb_chunk(pp, ps, layer, PB, tok0, tid);
        __syncthreads();
    }
}
__device__ __forceinline__ void fixup_b(LAS unsigned char* lds, const bf16_t* Q, bf16_t* Qo, const bf16_t* KV, const float* KR, bf16_t* K, bf16_t* VtB, const float* qg, const float* kg, const f32x2* rope,
                                        int hf, int vcu, int G) {
    int tid_l = threadIdx.x; asm volatile("" : "+v"(tid_l));
    const int tid = tid_l, lane = tid & 63, wid = tid >> 6, sub = lane & 7, hl = lane >> 3;
    LAS bf16_t* vt = (LAS bf16_t*)lds;
    const float qscale = 0.10206207261596575f * LOG2E;
    for (int chunk = vcu; chunk < TH / 32; chunk += G) {
        const int lt0 = chunk * 32; int st, S; seq_of(hf * TH + lt0, st, S); const int lst = st - hf * TH;
        for (int ib = 0; ib < 2; ++ib) {
            f32x2 csb[2][4]; f32x4 krb[2]; u32x4 qn[2][2], kn[2][2], vn[2][2]; u32x2 qr2[2][2];
#pragma unroll
            for (int t = 0; t < 2; ++t) { const int lt = lt0 + wid * 4 + ib * 2 + t, pos = lt - lst; const int fi = 4 * (sub & 3);
#pragma unroll
                for (int e = 0; e < 4; ++e) csb[t][e] = rope[pos * 16 + fi + e];
                krb[t] = *(const f32x4*)(KR + (size_t)lt * 32 + sub * 4);
#pragma unroll
                for (int rr = 0; rr < 2; ++rr) { const int h = rr * 8 + hl; const bf16_t* qp = Q + (size_t)lt * 1536 + h * 96; const bf16_t* kvp = KV + (size_t)lt * 2048 + h * 128;
                    qn[t][rr] = *(const u32x4*)(qp + sub * 8); qr2[t][rr] = *(const u32x2*)(qp + 64 + sub * 4); kn[t][rr] = *(const u32x4*)(kvp + sub * 8); vn[t][rr] = *(const u32x4*)(kvp + 64 + sub * 8); } }
#pragma unroll
            for (int t = 0; t < 2; ++t) { const int i = ib * 2 + t; const int lt = lt0 + wid * 4 + i; const f32x4 krv = krb[t];
#pragma unroll
                for (int rr = 0; rr < 2; ++rr) { const int h = rr * 8 + hl;
                    {
                        bf16_t* qp = Qo + (size_t)lt * 1536 + h * 96; const u32x4 rn = qn[t][rr]; const u32x2 rr2 = qr2[t][rr];
                        float a[8]; unpack8(rn, a); float b[4] = {bf_lo(rr2.x), bf_hi(rr2.x), bf_lo(rr2.y), bf_hi(rr2.y)};
                        float ss = 0.f;
#pragma unroll
                        for (int e = 0; e < 8; ++e) ss += a[e] * a[e];
#pragma unroll
                        for (int e = 0; e < 4; ++e) ss += b[e] * b[e];
                        ss += __shfl_xor(ss, 1); ss += __shfl_xor(ss, 2); ss += __shfl_xor(ss, 4);
                        const float rs = __builtin_amdgcn_rsqf(ss * (1.f / 96.f) + EPS);
#pragma unroll
                        for (int e = 0; e < 8; ++e) a[e] = a[e] * rs * qg[sub * 8 + e] * qscale;
#pragma unroll
                        for (int e = 0; e < 4; ++e) { b[e] = b[e] * rs * qg[64 + sub * 4 + e]; const float pb = __shfl_xor(b[e], 4);
                            b[e] = (sub < 4 ? b[e] * csb[t][e].x - pb * csb[t][e].y : pb * csb[t][e].y + b[e] * csb[t][e].x) * qscale; }
                        *(u32x4*)(qp + sub * 8) = pack8(a); u32x2 w; w.x = cvt_pk_bf16(b[0], b[1]); w.y = cvt_pk_bf16(b[2], b[3]); *(u32x2*)(qp + 64 + sub * 4) = w;
                    }
                    {
                        const u32x4 rn = kn[t][rr]; const u32x4 rv = vn[t][rr];
                        float a[8]; unpack8(rn, a); float b[4] = {krv[0], krv[1], krv[2], krv[3]};
                        float ss = 0.f;
#pragma unroll
                        for (int e = 0; e < 8; ++e) ss += a[e] * a[e];
#pragma unroll
                        for (int e = 0; e < 4; ++e) ss += b[e] * b[e];
                        ss += __shfl_xor(ss, 1); ss += __shfl_xor(ss, 2); ss += __shfl_xor(ss, 4);
                        const float rs = __builtin_amdgcn_rsqf(ss * (1.f / 96.f) + EPS);
#pragma unroll
                        for (int e = 0; e < 8; ++e) a[e] = a[e] * rs * kg[sub * 8 + e];
#pragma unroll
                        for (int e = 0; e < 4; ++e) { b[e] = b[e] * rs * kg[64 + sub * 4 + e]; const float pb = __shfl_xor(b[e], 4);
                            b[e] = sub < 4 ? b[e] * csb[t][e].x - pb * csb[t][e].y : pb * csb[t][e].y + b[e] * csb[t][e].x; }
                        bf16_t* kp = K + (size_t)lt * 1536 + h * 96;
                        *(u32x4*)(kp + sub * 8) = pack8(a); u32x2 w; w.x = cvt_pk_bf16(b[0], b[1]); w.y = cvt_pk_bf16(b[2], b[3]); *(u32x2*)(kp + 64 + sub * 4) = w;
                        const unsigned wv[4] = {rv.x, rv.y, rv.z, rv.w};
#pragma unroll
                        for (int e = 0; e < 8; ++e) vt[(h * 64 + sub * 8 + e) * 40 + wid * 4 + i] = (bf16_t)((e & 1) ? (wv[e >> 1] >> 16) : (wv[e >> 1] & 0xffffu));
                    } } } }
        __syncthreads();
#pragma unroll
        for (int k = 0; k < 8; ++k) { const int c = tid + 512 * k, row = c >> 2, cc = c & 3, h = row >> 6, d = row & 63;
            const u32x2 d0_ = *(const LAS u32x2*)(vt + row * 40 + (cc >> 1) * 16 + (cc & 1) * 4), d1_ = *(const LAS u32x2*)(vt + row * 40 + (cc >> 1) * 16 + 8 + (cc & 1) * 4);
            u32x4 dat; dat.x = d0_.x; dat.y = d0_.y; dat.z = d1_.x; dat.w = d1_.y;
            *(u32x4*)(VtB + (size_t)lst * 1024 + (size_t)h * 64 * S + (size_t)d * S + (lt0 - lst) + cc * 8) = dat; }
        __syncthreads();
    }
}


__global__ void __launch_bounds__(512, 2) mega(Args a) {
    extern __shared__ __attribute__((aligned(16))) unsigned char lds_raw[];
    LAS unsigned char* lds = (LAS unsigned char*)lds_raw;
    cg::grid_group grid = cg::this_grid();
    const int tid = threadIdx.x, lane = tid & 63, wid = __builtin_amdgcn_readfirstlane(tid >> 6);
    const int G = gridDim.x, bx = blockIdx.x, vcu = (G % 8 == 0) ? (bx % 8) * (G / 8) + bx / 8 : bx;
    const int gw = vcu * 8 + wid, NGW = G * 8;
#define ROPE ((f32x2*)(ws + WS_ROPE))
#define WL ((bf16_t*)(ws + WS_WL))
#define XB ((bf16_t*)(ws + WS_XB))
#define XB2 ((bf16_t*)(ws + WS_XB2))
#define SSV0 ((float*)(ws + WS_SS0))
#define SSV1 ((float*)(ws + WS_SS1))
#define SSL ((float*)(ws + WS_SSL))
#define PB ((bf16_t*)(ws + WS_PB))
#define Hb ((bf16_t*)(ws + WS_H))
#define PROJ ((bf16_t*)(ws + WS_PROJ))
#define QKV ((bf16_t*)(ws + WS_QKV))
#define VTA ((bf16_t*)(ws + WS_VTA))
#define LQ ((bf16_t*)(ws + WS_LQ))
#define LKV ((bf16_t*)(ws + WS_LKV))
#define KR ((float*)(ws + WS_KR))
#define Qh ((bf16_t*)(ws + WS_Q))
#define KVh ((bf16_t*)(ws + WS_KV))
#define Kh ((bf16_t*)(ws + WS_K))
#define VTB ((bf16_t*)(ws + WS_VTB))
#define SSa (s ? SSV1 : SSV0)
#define SSb (s ? SSV0 : SSV1)
    float* X = a.out;
    LAS float* scr = (LAS float*)(lds + wid * 16384);
    if (tid < 2) ((LAS unsigned*)(lds + 131072))[tid] = 0u;
    __syncthreads();
    const XcdBarrier xbar = xcd_barrier_post((unsigned*)(a.ws + WS_BAR), (volatile LAS unsigned*)(lds + 131072));
    int ph = 0; const int lo = a.ph_lo, hi = a.ph_hi;
#define PH_BEGIN if (ph >= lo && ph < hi) { unsigned char* ws = a.ws; asm volatile("" : "+s"(ws));
#define PH_END   if (ph + 1 < hi) { if (ph == 0) grid.sync(); else xcd_barrier(xbar); } } ++ph;
#define CVT_LAYER(L, part) cvt_layer(a, (L), WL, scr, gw, NGW, (part))
#ifndef EN
#define EN 0xffff
#endif
#ifndef DUP
#define DUP 0
#endif
#define REP(bit) for (int rep_ = ((DUP & (bit)) ? 0 : 1); rep_ < 2; ++rep_)
#define AMUL ((float)rep_)
#define GEMM(EpiT, g, E) do { pg8::StaticOrder S_; S_.init((g).M, (g).N, G, bx); pg8::gemm_phase<EpiT, pg8::StaticOrder, true, true>(lds, (g), S_, (E)); } while (0)

    PH_BEGIN

#if EN & 4096
        for (int idx = (vcu * 512 + tid); idx < 8192 * 16; idx += G * 512) { const int pos = idx >> 4, i = idx & 15; const float ang = (float)pos * INV_FREQ[i];
            double rev = (double)ang * 0.15915494309189535; rev -= __builtin_rint(rev); const float rf = (float)rev;
            f32x2 cs; cs.x = __builtin_amdgcn_cosf(rf); cs.y = __builtin_amdgcn_sinf(rf); ROPE[idx] = cs; }
        REP(4096) for (int row0 = gw * 4; row0 < TT; row0 += NGW * 4) {
            f32x4 v[4][4];
#pragma unroll
            for (int t = 0; t < 4; ++t) { const int e = ext_row(row0 + t); const float* src = e < 65536 ? a.in[0] + (size_t)e * DM : a.in[1] + (size_t)(e - 65536) * DM;
#pragma unroll
                for (int j = 0; j < 4; ++j) v[t][j] = *(const f32x4*)(src + (64 * j + lane) * 4); }
#pragma unroll
            for (int t = 0; t < 4; ++t) { const int row = row0 + t, e = ext_row(row); float s = 0.f;
#pragma unroll
                for (int j = 0; j < 4; ++j) s += (v[t][j][0] * v[t][j][0] + v[t][j][1] * v[t][j][1]) + (v[t][j][2] * v[t][j][2] + v[t][j][3] * v[t][j][3]);
                s = wave_sum(s);
#pragma unroll
                for (int j = 0; j < 4; ++j) { *(f32x4*)(X + (size_t)e * DM + (64 * j + lane) * 4) = v[t][j]; u32x2 w; w.x = cvt_pk_bf16(v[t][j][0], v[t][j][1]); w.y = cvt_pk_bf16(v[t][j][2], v[t][j][3]);
                    *(u32x2*)(XB2 + (size_t)row * DM + (64 * j + lane) * 4) = w; }
                if (lane < 16) SSV0[(size_t)row * 16 + lane] = lane == 0 ? s : 0.f; } }
        CVT_LAYER(0, 7);
#endif

    PH_END

#pragma nounroll
    for (int layer = 0; layer < 4; ++layer) {
        const int j = layer >> 1, s = layer & 1;
        if ((layer & 1) == 0) {
            PH_BEGIN
#if EN & 1
REP(1) { pg8::Gemm g{XB2, WL + WO_MIX, TT, 1536, 1024, 1024, 1024}; pg8::EpiScale E{QKV, 1536, pg8::RowScale{SSa, 0, 4, 1.f / 1024.f}}; GEMM(pg8::EpiScale, g, E); }
#endif
 if (layer > 0) CVT_LAYER(layer, 4); PH_END
            PH_BEGIN
#if EN & 2
fixup_a(lds, QKV, VTA, a.in[6] + j * 64, a.in[7] + j * 64, ROPE, vcu, G, a.in[2], a.in[3], layer, PB);
#endif
 PH_END
            PH_BEGIN

#if EN & 4
                int tl_ = threadIdx.x; asm volatile("" : "+v"(tl_)); const int lane = tl_ & 63, wid = __builtin_amdgcn_readfirstlane(tl_ >> 6);
                REP(4)
                for (int u = vcu; u < 6144; u += G) { const int psel = u & 1, rest = u >> 1, blk = rest % 768, kvh = rest / 768; const int tok0 = blk * 128; int st, S; seq_of(tok0, st, S);
                    const int n = (tok0 - st) >> 7, nt = S >> 6, kt0 = (2 * n - 2) > 0 ? (2 * n - 2) : 0, kt1 = (2 * n + 4) < nt ? (2 * n + 4) : nt;
                    const int head = kvh * 4 + psel * 2 + (wid >> 2), qpos = (n << 7) + (wid & 3) * 32 + (lane & 31);
                    bf16_t* qrow = QKV + (size_t)(st + qpos) * 1536 + head * 64;
                    attn_unit<64, true>(lds, qrow, rep_ ? qrow : PROJ + (size_t)(st + qpos) * 1024 + head * 64, QKV + (size_t)st * 1536 + 1024 + kvh * 64, 1536, VTA + (size_t)st * 256 + (size_t)kvh * 64 * S, S, kt0, kt1, qpos,
                                        a.in[8][j * 16 + head] * LOG2E, 1.f); }
#endif

            PH_END
            PH_BEGIN
#if EN & 8
REP(8) { pg8::Gemm g{QKV, WL + WO_MIX_O_A, TT, 1024, 1024, 1536, 1024}; pg8::EpiResid<false> E{X, 0, XB, SSb, nullptr, pg8::RowScale{nullptr, 0, 0, 0.f}, AMUL}; GEMM(pg8::EpiResid<false>, g, E); }
#endif
 PH_END
        } else {
            PH_BEGIN
#if EN & 16
REP(16) { pg8::Gemm g{XB2, WL + WO_MIX, TT, 768, 1024, 1024, 1024}; pg8::EpiLat E{LQ, LKV, KR, SSL, pg8::RowScale{SSa, 0, 4, 1.f / 1024.f}}; GEMM(pg8::EpiLat, g, E); }
#endif
 CVT_LAYER(layer, 4); PH_END
#pragma nounroll
            for (int hf = 0; hf < 2; ++hf) {
                PH_BEGIN

#if EN & 32
                    REP(32) { pg8::Gemm g{LQ + (size_t)hf * TH * 384, WL + WO_B_UQ, TH, 1536, 384, 384, 384}; pg8::EpiScale E{Qh, 1536, pg8::RowScale{SSL + (size_t)hf * TH * 16, 0, 2, 1.f / 384.f}}; GEMM(pg8::EpiScale, g, E); }
                    REP(32) { pg8::Gemm g{LKV + (size_t)hf * TH * 128, WL + WO_B_UKV, TH, 2048, 128, 128, 128}; pg8::EpiScale E{KVh, 2048, pg8::RowScale{SSL + (size_t)hf * TH * 16, 8, 1, 1.f / 128.f}}; GEMM(pg8::EpiScale, g, E); }
#endif

                PH_END
                PH_BEGIN

#if EN & 64
                    REP(64) fixup_b(lds, Qh, rep_ ? Qh : Kh, KVh, KR + (size_t)hf * TH * 32, Kh, VTB, a.in[15] + j * 96, a.in[16] + j * 96, ROPE, hf, vcu, G);
                    if (hf == 0) { int tp_ = threadIdx.x; asm volatile("" : "+v"(tp_)); for (int chunk = vcu; chunk < TT / 64; chunk += G) pb_chunk(a.in[2], a.in[3], layer, PB, chunk * 64, tp_); }
#endif

                PH_END
                PH_BEGIN

#if EN & 128
                    int tl_ = threadIdx.x; asm volatile("" : "+v"(tl_)); const int lane = tl_ & 63, wid = __builtin_amdgcn_readfirstlane(tl_ >> 6);
                    REP(128)
                    for (int u = vcu; u < 3072; u += G) { int sq0, S, h, qb;
                        if (u < 2048) { const int pair = u >> 5; qb = u & 31; S = 8192; sq0 = (pair >> 4) * 8192; h = pair & 15; }
                        else { const int v = u - 2048, pair = v >> 3; qb = v & 7; S = 2048; sq0 = 32768 + (pair >> 4) * 2048; h = pair & 15; }
                        const size_t qr = (size_t)(sq0 + qb * 256 + wid * 32 + (lane & 31));
                        attn_unit<96, false>(lds, Qh + qr * 1536 + h * 96, KVh + qr * 1024 + h * 64, Kh + (size_t)sq0 * 1536 + h * 96, 1536, VTB + (size_t)sq0 * 1024 + (size_t)h * 64 * S, S, 0, S >> 6, 0, 0.f, 0.f); }
#endif

                PH_END
                PH_BEGIN
#if EN & 256
REP(256) { pg8::Gemm g{KVh, WL + WO_B_O, TH, 1024, 1024, 1024, 1024}; pg8::EpiResid<false> E{X, hf * TH, XB + (size_t)hf * TH * DM, SSb + (size_t)hf * TH * 16, nullptr, pg8::RowScale{nullptr, 0, 0, 0.f}, AMUL}; GEMM(pg8::EpiResid<false>, g, E); }
#endif
 PH_END
            }
        }
        PH_BEGIN
#if EN & 512
REP(512) { pg8::Gemm g{XB, WL + WO_GU, TT, 5632, 1024, 1024, 1024}; pg8::EpiSwiglu E{Hb, pg8::RowScale{SSb, 0, 4, 1.f / 1024.f}}; GEMM(pg8::EpiSwiglu, g, E); }
#endif
 if (layer < 3) CVT_LAYER(layer + 1, 1); PH_END
        PH_BEGIN

#if EN & 1024
            REP(1024) { pg8::Gemm g{Hb, WL + WO_D, TT, 1024, FFH, FFH, FFH}; pg8::EpiResid<false> E{X, 0, XB, SSa, nullptr, pg8::RowScale{nullptr, 0, 0, 0.f}, AMUL}; GEMM(pg8::EpiResid<false>, g, E); }
            REP(1024) { pg8::Gemm g{PB, WL + WO_PP, TT, 1024, PLE, PLE, PLE}; pg8::EpiScale E{PROJ, 1024, pg8::RowScale{nullptr, 0, 0, 0.f}}; GEMM(pg8::EpiScale, g, E); }
#endif

        PH_END
        PH_BEGIN
#if EN & 2048
REP(2048) { pg8::Gemm g{XB, WL + WO_PG, TT, 1024, 1024, 1024, 1024}; pg8::EpiResid<true> E{X, 0, XB2, SSb, PROJ, pg8::RowScale{SSa, 0, 4, 1.f / 1024.f}, AMUL}; GEMM(pg8::EpiResid<true>, g, E); }
#endif
 if (layer < 3) CVT_LAYER(layer + 1, 2); PH_END
    }
}

#ifndef N_LAUNCH_MODE
#define N_LAUNCH_MODE 1
#endif
constexpr int NPH = 39;
extern "C" void kernel_launch(void* const* d_in, const int* in_sizes, int n_in, void* d_out, int out_size, void* d_ws, size_t ws_size, hipStream_t stream) {
    static int grid = 0;
    if (grid == 0) {
        if (n_in != 24 || out_size != TT * DM || ws_size < WS_TOTAL) { fprintf(stderr, "kernel_launch: unexpected sizes n_in %d out %d ws %zu (need %zu)\n", n_in, out_size, ws_size, (size_t)WS_TOTAL); grid = -1; return; }
        int dev = 0, cus = 0, per_cu = 0;
        (void)hipGetDevice(&dev); (void)hipDeviceGetAttribute(&cus, hipDeviceAttributeMultiprocessorCount, dev);
        if (hipFuncSetAttribute((const void*)mega, hipFuncAttributeMaxDynamicSharedMemorySize, LDS_BYTES) != hipSuccess) { fprintf(stderr, "kernel_launch: hipFuncSetAttribute failed\n"); grid = -1; return; }
        if (hipOccupancyMaxActiveBlocksPerMultiprocessor(&per_cu, (const void*)mega, 512, LDS_BYTES) != hipSuccess || per_cu < 1) { fprintf(stderr, "kernel_launch: occupancy query %d\n", per_cu); per_cu = 1; }
        (void)hipGetLastError();
        grid = cus * 1;
        if (grid <= 0) grid = 256;
    }
    if (grid < 0) return;
    if (hipMemsetAsync((char*)d_ws + WS_BAR, 0, WS_BAR_BYTES, stream) != hipSuccess) { fprintf(stderr, "kernel_launch: memset failed\n"); return; }
    Args a{};
    for (int i = 0; i < 24; ++i) a.in[i] = (const float*)d_in[i];
    a.out = (float*)d_out; a.ws = (unsigned char*)d_ws;
#if N_LAUNCH_MODE == 1
    a.ph_lo = 0; a.ph_hi = 1 << 20;
    void* args[] = {&a};
    hipError_t e = hipLaunchCooperativeKernel((const void*)mega, dim3(grid), dim3(512), args, LDS_BYTES, stream);
    if (e != hipSuccess) fprintf(stderr, "cooperative launch failed: %s (grid %d)\n", hipGetErrorString(e), grid);
#else
    for (int p = 0; p < NPH; ++p) { a.ph_lo = p; a.ph_hi = p + 1; hipLaunchKernelGGL(mega, dim3(grid), dim3(512), LDS_BYTES, stream, a); }
#endif
}
```

```cpp
#include <hip/hip_runtime.h>
#include <hip/hip_cooperative_groups.h>
#include <cstdio>
#include <cstdint>
namespace cg = cooperative_groups;

constexpr int TT = 98304;
constexpr int TH = 49152;
constexpr int DM = 1024, FFH = 2816, PLE = 256;
constexpr float EPS = 1e-6f;
constexpr float LOG2E = 1.4426950408889634f;

__device__ __forceinline__ int ext_row(int r) { const int h = r >= TH ? 1 : 0; const int o = r - h * TH; return o < 32768 ? h * 32768 + o : 65536 + h * 16384 + (o - 32768); }
__device__ __forceinline__ void seq_of(int tok, int& st, int& S) { const int h = tok >= TH ? 1 : 0; const int o = tok - h * TH;
    if (o < 32768) { S = 8192; st = h * TH + (o & ~8191); } else { S = 2048; st = h * TH + 32768 + ((o - 32768) & ~2047); } }

namespace pg8 {
#define PG8_LAS __attribute__((address_space(3)))
typedef unsigned short bf16_t;
typedef short bf16x8 __attribute__((ext_vector_type(8)));
typedef float f32x4 __attribute__((ext_vector_type(4)));
typedef unsigned u32x4 __attribute__((ext_vector_type(4)));
constexpr int BM = 256, BK = 64, HALF = 128, HTB = HALF * BK * 2  , STAGE_BYTES = 8 * HTB, NXCD = 8, WGM = 8;

__host__ __device__ __forceinline__ int lds_byte(int r, int c) { const int st = (r >> 4) * 2 + (c >> 5), rr = r & 15, cc = c & 31, ob = rr * 64 + cc * 2; return st * 1024 + (ob ^ (((ob >> 9) & 1) << 5)); }
__host__ __device__ __forceinline__ void stage_rc(int b, int& R, int& C) { const int st = b / 1024, sb = b % 1024, swz = sb ^ (((sb >> 9) & 1) << 5); R = (st >> 1) * 16 + swz / 64; C = (st & 1) * 32 + (swz % 64) / 2; }
__host__ __device__ __forceinline__ int perm32(int rho) { const int n = rho >> 4, i = rho & 15; return 8 * (i >> 2) + 4 * n + (i & 3); }

struct Unit { int pm, pn; };
struct Gemm { const bf16_t* A; const bf16_t* Bt; int M, N, K, lda, ldb; };

struct StaticOrder {
    int nM, nN, nwg, G, c;
    __host__ __device__ void init(int M, int N, int G_, int c_) { nM = M / BM; nN = N / BM; nwg = nM * nN; G = G_; c = c_; }
    __host__ __device__ bool next(int i, Unit& u) const {
        const long L = (long)i * G + c; if (L >= nwg) return false;
        int wgid = (int)L; { const int q = nwg / NXCD, r = nwg % NXCD, xcd = wgid % NXCD, off = wgid / NXCD; wgid = (xcd < r ? xcd * (q + 1) : r * (q + 1) + (xcd - r) * q) + off; }
        const int nig = WGM * nN, gid = wgid / nig, fm = gid * WGM, gsz = (nM - fm) < WGM ? (nM - fm) : WGM;
        u.pm = fm + ((wgid % nig) % gsz); u.pn = (wgid % nig) / gsz; return true;
    }
    __device__ __forceinline__ void a_ready(const Unit&) const {}
    __device__ __forceinline__ void done(const Unit&) const {}
};

__device__ __forceinline__ unsigned cvt_pk_bf16(float lo, float hi) { unsigned r; asm volatile("v_cvt_pk_bf16_f32 %0, %1, %2" : "=v"(r) : "v"(lo), "v"(hi)); return r; }
typedef unsigned u32x2 __attribute__((ext_vector_type(2)));
__device__ __forceinline__ float bf_lo(unsigned w) { return __uint_as_float(w << 16); }
__device__ __forceinline__ float bf_hi(unsigned w) { return __uint_as_float(w & 0xffff0000u); }

struct RowScale { const float* ss; int s0, ns4; float inv_dim;
    __device__ __forceinline__ float get(int row) const {
        if (!ss) return 1.f;
        const f32x4* p = (const f32x4*)(ss + (size_t)row * 16 + s0); float s = 0.f;
        for (int i = 0; i < ns4; ++i) { const f32x4 v = p[i]; s += (v[0] + v[1]) + (v[2] + v[3]); }
        return __builtin_amdgcn_rsqf(s * inv_dim + EPS);
    } };

struct EpiScale {
    static constexpr bool PERM = true, AFTER_DRAIN = false;
    bf16_t* O; int ldc; RowScale rs;
    __device__ __forceinline__ void operator()(const f32x4 (&acc)[2][2][4][2], const Unit& u, int wr, int wc, int fr, int fq) const {
        const int row0 = u.pm * BM + wr * 64 + fr, col0 = u.pn * BM + wc * 32 + 8 * fq;
#pragma unroll
        for (int ai = 0; ai < 2; ++ai)
#pragma unroll
            for (int m = 0; m < 4; ++m) { const int row = row0 + ai * HALF + m * 16; const float s = rs.get(row); bf16_t* rp = O + (size_t)row * ldc + col0;
#pragma unroll
                for (int bj = 0; bj < 2; ++bj) { const f32x4 v0 = acc[ai][bj][m][0] * s, v1 = acc[ai][bj][m][1] * s; u32x4 w; w.x = cvt_pk_bf16(v0[0], v0[1]); w.y = cvt_pk_bf16(v0[2], v0[3]); w.z = cvt_pk_bf16(v1[0], v1[1]); w.w = cvt_pk_bf16(v1[2], v1[3]);
                    *(u32x4*)(rp + bj * HALF) = w; } }
    }
};

struct EpiLat {
    static constexpr bool PERM = false, AFTER_DRAIN = false;
    bf16_t* LQ; bf16_t* LKV; float* KR; float* SSL; RowScale rs;
    __device__ __forceinline__ void operator()(const f32x4 (&acc)[2][2][4][2], const Unit& u, int wr, int wc, int fr, int fq) const {
        const int row0 = u.pm * BM + wr * 64 + fr, col0 = u.pn * BM + wc * 32 + 4 * fq;
#pragma unroll
        for (int ai = 0; ai < 2; ++ai)
#pragma unroll
            for (int m = 0; m < 4; ++m) { const int row = row0 + ai * HALF + m * 16; const float s = rs.get(row); float q[2] = {0.f, 0.f};
#pragma unroll
                for (int bj = 0; bj < 2; ++bj)
#pragma unroll
                    for (int n = 0; n < 2; ++n) { const f32x4 v = acc[ai][bj][m][n] * s; q[bj] += (v[0] * v[0] + v[1] * v[1]) + (v[2] * v[2] + v[3] * v[3]);
                        const int col = col0 + bj * HALF + n * 16; u32x2 w; w.x = cvt_pk_bf16(v[0], v[1]); w.y = cvt_pk_bf16(v[2], v[3]);
                        if (col < 384) *(u32x2*)(LQ + (size_t)row * 384 + col) = w;
                        else if (col < 512) *(u32x2*)(LKV + (size_t)row * 128 + (col - 384)) = w;
                        else if (col < 544) *(f32x4*)(KR + (size_t)row * 32 + (col - 512)) = v; }
                float q0 = q[0], q1 = q[1];
                q0 += __shfl_xor(q0, 16); q0 += __shfl_xor(q0, 32); q1 += __shfl_xor(q1, 16); q1 += __shfl_xor(q1, 32);
                if (fq == 0) { if (u.pn == 0) SSL[(size_t)row * 16 + wc] = q0 + q1; else if (u.pn == 1) { SSL[(size_t)row * 16 + 4 + wc] = q0; SSL[(size_t)row * 16 + 8 + wc] = q1; } } }
    }
};

struct EpiSwiglu {
    static constexpr bool PERM = true, AFTER_DRAIN = false;
    bf16_t* H; RowScale rs;
    __device__ __forceinline__ void operator()(const f32x4 (&acc)[2][2][4][2], const Unit& u, int wr, int wc, int fr, int fq) const {
        const int row0 = u.pm * BM + wr * 64 + fr, col0 = u.pn * HALF + wc * 32 + 8 * fq;
#pragma unroll
        for (int ai = 0; ai < 2; ++ai)
#pragma unroll
            for (int m = 0; m < 4; ++m) { const int row = row0 + ai * HALF + m * 16; const float s = rs.get(row); bf16_t* rp = H + (size_t)row * FFH + col0; float h[8];
                const float c1 = -s * LOG2E, c2 = s * s;
#pragma unroll
                for (int n = 0; n < 2; ++n) { const f32x4 a0 = acc[ai][0][m][n], a1 = acc[ai][1][m][n];
#pragma unroll
                    for (int j = 0; j < 4; ++j) h[4 * n + j] = (a0[j] * a1[j]) * c2 * __builtin_amdgcn_rcpf(1.f + __builtin_amdgcn_exp2f(a0[j] * c1)); }
                u32x4 w; w.x = cvt_pk_bf16(h[0], h[1]); w.y = cvt_pk_bf16(h[2], h[3]); w.z = cvt_pk_bf16(h[4], h[5]); w.w = cvt_pk_bf16(h[6], h[7]); __builtin_nontemporal_store(w, (u32x4*)rp); }
    }
};

template <bool PLEG> struct EpiResid {
    static constexpr bool PERM = true, AFTER_DRAIN = false;
    static constexpr int MB = PLEG ? 2 : 4;
    float* X; int row_int0; bf16_t* XBo; float* SSn; const bf16_t* PROJ; RowScale rs; float amul;
    __device__ __forceinline__ void operator()(const f32x4 (&acc)[2][2][4][2], const Unit& u, int wr, int wc, int fr, int fq) const {
        const int ext0 = ext_row(row_int0 + u.pm * BM); const int col0 = u.pn * BM + wc * 32 + 8 * fq;
#pragma unroll
        for (int ai = 0; ai < 2; ++ai)
#pragma unroll
            for (int mb = 0; mb < 4; mb += MB) {
                f32x4 xo[MB][2][2]; u32x4 pw[MB][2]; float sv[MB];
#pragma unroll
                for (int mm = 0; mm < MB; ++mm) { const int m = mb + mm; const int lrow = wr * 64 + fr + ai * HALF + m * 16, row = u.pm * BM + lrow; const float* xp = X + (size_t)(ext0 + lrow) * DM + col0;
                    sv[mm] = PLEG ? rs.get(row) : 0.f;
#pragma unroll
                    for (int bj = 0; bj < 2; ++bj) { xo[mm][bj][0] = *(const f32x4*)(xp + bj * HALF); xo[mm][bj][1] = *(const f32x4*)(xp + bj * HALF + 4);
                        if (PLEG) pw[mm][bj] = *(const u32x4*)(PROJ + (size_t)row * DM + col0 + bj * HALF); } }
                asm volatile("" ::: "memory");
#pragma unroll
                for (int mm = 0; mm < MB; ++mm) { const int m = mb + mm; const int lrow = wr * 64 + fr + ai * HALF + m * 16, row = u.pm * BM + lrow; float* xp = X + (size_t)(ext0 + lrow) * DM + col0;
                    const float s = sv[mm]; float q = 0.f;
#pragma unroll
                    for (int bj = 0; bj < 2; ++bj) { f32x4 xn[2];
#pragma unroll
                        for (int n = 0; n < 2; ++n) { const f32x4 a = acc[ai][bj][m][n];
                            if (PLEG) { const unsigned w0 = n == 0 ? pw[mm][bj].x : pw[mm][bj].z, w1 = n == 0 ? pw[mm][bj].y : pw[mm][bj].w; const float p[4] = {bf_lo(w0), bf_hi(w0), bf_lo(w1), bf_hi(w1)};
#pragma unroll
                                for (int j = 0; j < 4; ++j) xn[n][j] = xo[mm][bj][n][j] + __builtin_amdgcn_rcpf(1.f + __builtin_amdgcn_exp2f(-a[j] * s * LOG2E)) * p[j] * amul; }
                            else xn[n] = xo[mm][bj][n] + a * amul;
                            *(f32x4*)(xp + bj * HALF + 4 * n) = xn[n];
                            q += (xn[n][0] * xn[n][0] + xn[n][1] * xn[n][1]) + (xn[n][2] * xn[n][2] + xn[n][3] * xn[n][3]); }
                        u32x4 w; w.x = cvt_pk_bf16(xn[0][0], xn[0][1]); w.y = cvt_pk_bf16(xn[0][2], xn[0][3]); w.z = cvt_pk_bf16(xn[1][0], xn[1][1]); w.w = cvt_pk_bf16(xn[1][2], xn[1][3]);
                        *(u32x4*)(XBo + (size_t)row * DM + col0 + bj * HALF) = w; }
                    q += __shfl_xor(q, 16); q += __shfl_xor(q, 32);
                    if (fq == 0) SSn[(size_t)row * 16 + u.pn * 4 + wc] = q; }
                asm volatile("" ::: "memory");
            }
    }
};

template <class Epi, class Sched, bool ALIGN_EPI = false, bool SP2 = false>
__device__ __forceinline__ void gemm_phase(PG8_LAS unsigned char* lds, const Gemm g, const Sched& S, const Epi& E) {
    int tid_l = threadIdx.x; asm volatile("" : "+v"(tid_l));
    const int tid = tid_l, wid = __builtin_amdgcn_readfirstlane(tid >> 6), lane = tid & 63, wr = wid >> 2, wc = wid & 3, fr = lane & 15, fq = lane >> 4;
    const int K = g.K, nt = K / BK;
    unsigned voffA[2], voffB[2];
#pragma unroll
    for (int i = 0; i < 2; ++i) { int R, C; stage_rc(tid * 16 + i * 8192, R, C); const int Rb = Epi::PERM ? ((R & ~31) + perm32(R & 31)) : R;
        voffA[i] = (unsigned)(R * g.lda + C) * 2u; voffB[i] = (unsigned)(Rb * g.ldb + C) * 2u; }
    const size_t kstep = (size_t)(BK * 2);
    const size_t hstepA = (size_t)HALF * g.lda * 2, hstepB = (size_t)HALF * g.ldb * 2;
    const size_t tstepA = 2 * hstepA, tstepB = 2 * hstepB;
    const unsigned ldsw = (unsigned)wid * 1024u;
    const int aoff = lds_byte(wr * 64 + fr, fq * 8), boff = lds_byte(wc * 32 + fr, fq * 8);
#define PG8_SA(b, h) (((b) * 2 + (h)) * HTB)
#define PG8_SB(b, h) ((4 + (b) * 2 + (h)) * HTB)
#define PG8_STAGE(bufoff, gbase, voff) do { _Pragma("unroll") for (int _i = 0; _i < 2; ++_i) \
        __builtin_amdgcn_global_load_lds((const unsigned*)((const char*)(gbase) + (voff)[_i]), (PG8_LAS unsigned*)(lds + (bufoff) + ldsw + _i * 8192), 16, 0, 0); } while (0)
#define PG8_LDA(dst, b, h) do { _Pragma("unroll") for (int m = 0; m < 4; ++m) _Pragma("unroll") for (int k = 0; k < 2; ++k) dst[m][k] = *(const PG8_LAS bf16x8*)(lds + PG8_SA(b, h) + aoff + m * 2048 + k * 1024); } while (0)
#define PG8_LDB(dst, b, h) do { _Pragma("unroll") for (int n = 0; n < 2; ++n) _Pragma("unroll") for (int k = 0; k < 2; ++k) dst[n][k] = *(const PG8_LAS bf16x8*)(lds + PG8_SB(b, h) + boff + n * 2048 + k * 1024); } while (0)
#define PG8_MMA(ai, bj, At, Bt) do { __builtin_amdgcn_s_setprio(1); _Pragma("unroll") for (int m = 0; m < 4; ++m) _Pragma("unroll") for (int n = 0; n < 2; ++n) _Pragma("unroll") for (int k = 0; k < 2; ++k) \
        acc[ai][bj][m][n] = __builtin_amdgcn_mfma_f32_16x16x32_bf16(Bt[n][k], At[m][k], acc[ai][bj][m][n], 0, 0, 0); __builtin_amdgcn_s_setprio(0); } while (0)
#define PG8_WAIT_V(n) asm volatile("s_waitcnt vmcnt(" #n ")" ::: "memory")
#define PG8_WAIT_L(n) asm volatile("s_waitcnt lgkmcnt(" #n ")" ::: "memory")
#define PG8_BAR __builtin_amdgcn_s_barrier()
#define PG8_SCHED __builtin_amdgcn_sched_barrier(0)
    Unit cur, nxt; int ui = 0;
    if (!S.next(0, cur)) return;
    f32x4 acc[2][2][4][2];
#pragma unroll
    for (int a = 0; a < 2; ++a)
#pragma unroll
        for (int b = 0; b < 2; ++b)
#pragma unroll
            for (int m = 0; m < 4; ++m)
#pragma unroll
                for (int n = 0; n < 2; ++n) acc[a][b][m][n] = (f32x4){0.f, 0.f, 0.f, 0.f};
    bf16x8 At[4][2], B0[2][2], B1[2][2];
    const char* cA = (const char*)g.A + (size_t)cur.pm * tstepA; const char* cB = (const char*)g.Bt + (size_t)cur.pn * tstepB;
    S.a_ready(cur);
    if constexpr (SP2) {
        PG8_STAGE(PG8_SB(0, 0), cB, voffB); PG8_STAGE(PG8_SB(0, 1), cB + hstepB, voffB); PG8_STAGE(PG8_SA(0, 0), cA, voffA); PG8_STAGE(PG8_SA(0, 1), cA + hstepA, voffA);
        if (wr == 1) PG8_BAR;
        PG8_WAIT_V(2); PG8_BAR;
        PG8_STAGE(PG8_SB(1, 0), cB + kstep, voffB); PG8_STAGE(PG8_SA(1, 0), cA + kstep, voffA); PG8_STAGE(PG8_SB(1, 1), cB + hstepB + kstep, voffB);
        PG8_WAIT_V(6); PG8_BAR;
    } else {
        PG8_STAGE(PG8_SB(0, 0), cB, voffB); PG8_STAGE(PG8_SA(0, 0), cA, voffA); PG8_STAGE(PG8_SB(0, 1), cB + hstepB, voffB); PG8_STAGE(PG8_SA(0, 1), cA + hstepA, voffA);
        if (wr == 1) PG8_BAR;
        PG8_WAIT_V(4); PG8_BAR;
        PG8_STAGE(PG8_SB(1, 0), cB + kstep, voffB); PG8_STAGE(PG8_SA(1, 0), cA + kstep, voffA); PG8_STAGE(PG8_SB(1, 1), cB + hstepB + kstep, voffB);
        PG8_WAIT_V(6); PG8_BAR;
    }
    for (;;) {
        const bool has_next = S.next(ui + 1, nxt);
        const char* nA = has_next ? (const char*)g.A + (size_t)nxt.pm * tstepA : cA; const char* nB = has_next ? (const char*)g.Bt + (size_t)nxt.pn * tstepB : cB;
        for (int t = 0; t < nt; t += 2) {
            const bool last = (t == nt - 2);
            const char* a1 = cA + (size_t)(t + 1) * kstep;
            const char* a2 = last ? nA : cA + (size_t)(t + 2) * kstep; const char* b2 = last ? nB : cB + (size_t)(t + 2) * kstep;
            const char* a3 = a2 + kstep; const char* b3 = b2 + kstep;
            if (last && has_next) S.a_ready(nxt);
            if constexpr (SP2) {
            PG8_LDB(B0, 0, 0); PG8_LDB(B1, 0, 1); PG8_SCHED; PG8_LDA(At, 0, 0); PG8_STAGE(PG8_SA(1, 1), a1 + hstepA, voffA);
            PG8_WAIT_V(8); PG8_WAIT_L(0); PG8_BAR; PG8_MMA(0, 0, At, B0); PG8_MMA(0, 1, At, B1); PG8_BAR; PG8_SCHED;
            PG8_LDA(At, 0, 1); PG8_STAGE(PG8_SB(0, 0), b2, voffB); PG8_STAGE(PG8_SB(0, 1), b2 + hstepB, voffB); PG8_STAGE(PG8_SA(0, 0), a2, voffA);
            PG8_WAIT_V(8); PG8_WAIT_L(0); PG8_BAR; PG8_MMA(1, 0, At, B0); PG8_MMA(1, 1, At, B1); PG8_BAR; PG8_SCHED;
            PG8_LDB(B0, 1, 0); PG8_LDB(B1, 1, 1); PG8_SCHED; PG8_LDA(At, 1, 0); PG8_STAGE(PG8_SA(0, 1), a2 + hstepA, voffA);
            PG8_WAIT_V(8); PG8_WAIT_L(0); PG8_BAR; PG8_MMA(0, 0, At, B0); PG8_MMA(0, 1, At, B1); PG8_BAR; PG8_SCHED;
            PG8_LDA(At, 1, 1); PG8_STAGE(PG8_SB(1, 0), b3, voffB); PG8_STAGE(PG8_SB(1, 1), b3 + hstepB, voffB); PG8_STAGE(PG8_SA(1, 0), a3, voffA);
            PG8_WAIT_V(8); PG8_WAIT_L(0); PG8_BAR; PG8_MMA(1, 0, At, B0); PG8_MMA(1, 1, At, B1); PG8_BAR; PG8_SCHED;
            } else {
            PG8_LDB(B0, 0, 0); PG8_SCHED; PG8_LDA(At, 0, 0); PG8_STAGE(PG8_SA(1, 1), a1 + hstepA, voffA);
            PG8_WAIT_L(8); PG8_BAR; PG8_WAIT_L(0); PG8_MMA(0, 0, At, B0); PG8_BAR; PG8_SCHED;
            PG8_LDB(B1, 0, 1); PG8_STAGE(PG8_SB(0, 0), b2, voffB);
            PG8_BAR; PG8_WAIT_L(0); PG8_MMA(0, 1, At, B1); PG8_BAR;
            PG8_LDA(At, 0, 1); PG8_STAGE(PG8_SA(0, 0), a2, voffA);
            PG8_BAR; PG8_WAIT_L(0); PG8_MMA(1, 0, At, B0); PG8_BAR; PG8_SCHED;
            PG8_STAGE(PG8_SB(0, 1), b2 + hstepB, voffB);
            PG8_WAIT_V(6); PG8_BAR; PG8_MMA(1, 1, At, B1); PG8_BAR;
            PG8_LDB(B0, 1, 0); PG8_SCHED; PG8_LDA(At, 1, 0); PG8_STAGE(PG8_SA(0, 1), a2 + hstepA, voffA);
            PG8_WAIT_L(8); PG8_BAR; PG8_WAIT_L(0); PG8_MMA(0, 0, At, B0); PG8_BAR; PG8_SCHED;
            PG8_LDB(B1, 1, 1); PG8_STAGE(PG8_SB(1, 0), b3, voffB);
            PG8_BAR; PG8_WAIT_L(0); PG8_MMA(0, 1, At, B1); PG8_BAR;
            PG8_LDA(At, 1, 1); PG8_STAGE(PG8_SA(1, 0), a3, voffA);
            PG8_BAR; PG8_WAIT_L(0); PG8_MMA(1, 0, At, B0); PG8_BAR; PG8_SCHED;
            PG8_STAGE(PG8_SB(1, 1), b3 + hstepB, voffB);
            PG8_WAIT_V(6); PG8_BAR; PG8_MMA(1, 1, At, B1); PG8_BAR;
            }
        }
        if constexpr (ALIGN_EPI) { if (wr == 0) PG8_BAR; }
        if constexpr (!Epi::AFTER_DRAIN) { E(acc, cur, wr, wc, fr, fq); S.done(cur); }
        if (!has_next) break;
#pragma unroll
        for (int a = 0; a < 2; ++a)
#pragma unroll
            for (int b = 0; b < 2; ++b)
#pragma unroll
                for (int m = 0; m < 4; ++m)
#pragma unroll
                    for (int n = 0; n < 2; ++n) acc[a][b][m][n] = (f32x4){0.f, 0.f, 0.f, 0.f};
        cur = nxt; cA = nA; cB = nB; ++ui;
        if constexpr (ALIGN_EPI) { if (wr == 1) PG8_BAR; }
    }
    PG8_WAIT_V(0);
    if constexpr (!ALIGN_EPI) { if (wr == 0) PG8_BAR; }
    PG8_BAR;
    if constexpr (Epi::AFTER_DRAIN) { E.fused(acc, cur, wr, wc, fr, fq, lds, wid, lane); S.done(cur); }
#undef PG8_SA
#undef PG8_SB
#undef PG8_STAGE
#undef PG8_LDA
#undef PG8_LDB
#undef PG8_MMA
#undef PG8_WAIT_V
#undef PG8_WAIT_L
#undef PG8_BAR
#undef PG8_SCHED
}
}

#define LAS __attribute__((address_space(3)))
typedef unsigned short bf16_t;
using pg8::bf16x8; using pg8::f32x4; using pg8::u32x4; using pg8::u32x2; using pg8::cvt_pk_bf16; using pg8::bf_lo; using pg8::bf_hi;
typedef float f32x16 __attribute__((ext_vector_type(16)));
typedef float f32x2 __attribute__((ext_vector_type(2)));

#define XB_TMO      128
#define XB_XCNT(j)  (256  + 64 * (j))
#define XB_XSUB(j)  (1280 + 64 * (j))
#define XB_XGEN(j)  (2304 + 64 * (j))
#define XB_TOP      3328
#define XB_TOPGEN   3392
#define XCD_BAR_WORDS 3456
#define XB_SPIN_CAP (1u << 18)

__device__ __forceinline__ unsigned xb_ld(unsigned* p)              { return __hip_atomic_load(p, __ATOMIC_RELAXED, __HIP_MEMORY_SCOPE_AGENT); }
__device__ __forceinline__ unsigned xb_add(unsigned* p, unsigned v) { return __hip_atomic_fetch_add(p, v, __ATOMIC_RELAXED, __HIP_MEMORY_SCOPE_AGENT); }
__device__ __forceinline__ unsigned xb_xcc_id() { return (unsigned)__builtin_amdgcn_s_getreg((3 << 11) | 20) & 0xFu; }
#define XB_SPIN(cond, bar) do { unsigned _sp = 0; while (cond) { __builtin_amdgcn_s_sleep(1); \
    if ((++_sp & 255u) == 0u) { if (xb_ld(&(bar)[XB_TMO])) break; if (_sp > XB_SPIN_CAP) { atomicAdd(&(bar)[XB_TMO], 1u); break; } } } } while (0)

struct XcdBarrier {
    unsigned* bar; unsigned x;
    volatile LAS unsigned* st;
};

__device__ __forceinline__ XcdBarrier xcd_barrier_post(unsigned* bar, volatile LAS unsigned* st) {
    XcdBarrier b; b.bar = bar; b.x = xb_xcc_id(); b.st = st;
    if (threadIdx.x == 0) (void)xb_add(&bar[XB_XCNT(b.x)], 1u);
    return b;
}
__device__ __forceinline__ void xcd_barrier_complete(unsigned* bar, unsigned x, unsigned& nloc, unsigned& nx) {
    const unsigned G = gridDim.x * gridDim.y * gridDim.z;
    unsigned sum, cnt, mine, sp = 0u;
    for (;;) {
        sum = 0u; cnt = 0u; mine = 0u;
#pragma unroll
        for (unsigned j = 0; j < 16; ++j) { const unsigned c = xb_ld(&bar[XB_XCNT(j)]); sum += c; cnt += (c > 0u) ? 1u : 0u; mine = (j == x) ? c : mine; }
        if (sum == G) break;
        __builtin_amdgcn_s_sleep(1);
        if ((++sp & 255u) == 0u) { if (xb_ld(&bar[XB_TMO])) break; if (sp > XB_SPIN_CAP) { atomicAdd(&bar[XB_TMO], 1u); break; } }
    }
    nloc = mine > 0u ? mine : 1u; nx = cnt > 0u ? cnt : 1u;
}

__device__ __forceinline__ void xcd_barrier(const XcdBarrier& b) {
    asm volatile("s_waitcnt vmcnt(0)" ::: "memory");
    __syncthreads();
    if (threadIdx.x == 0) {
        unsigned* bar = b.bar;
        __builtin_amdgcn_s_waitcnt(0);
        unsigned nloc = b.st[0], nx = b.st[1];
        if (nloc == 0u) { xcd_barrier_complete(bar, b.x, nloc, nx); b.st[0] = nloc; b.st[1] = nx; }
        const unsigned old = xb_add(&bar[XB_XSUB(b.x)], 1u);
        const unsigned gen = old / nloc;
        if (old + 1u == (gen + 1u) * nloc) {
            __builtin_amdgcn_fence(__ATOMIC_RELEASE, "agent");
            asm volatile("s_waitcnt vmcnt(0)" ::: "memory");
            const unsigned og = xb_add(&bar[XB_TOP], 1u);
            const unsigned tg = og / nx;
            if (og + 1u == (tg + 1u) * nx) xb_add(&bar[XB_TOPGEN], 1u);
            else XB_SPIN(xb_ld(&bar[XB_TOPGEN]) == tg, bar);
            __builtin_amdgcn_fence(__ATOMIC_ACQUIRE, "agent");
            xb_add(&bar[XB_XGEN(b.x)], 1u);
            asm volatile("s_waitcnt vmcnt(0)" ::: "memory");
        } else {
            XB_SPIN(xb_ld(&bar[XB_XGEN(b.x)]) == gen, bar);
            __builtin_amdgcn_fence(__ATOMIC_ACQUIRE, "agent");
            asm volatile("s_waitcnt vmcnt(0)" ::: "memory");
        }
    }
    __syncthreads();
}

constexpr size_t MiB = 1u << 20;
constexpr size_t WS_ROPE = 0;
constexpr size_t WS_WL = 1 * MiB;
constexpr size_t WS_XB = 26 * MiB;
constexpr size_t WS_SS0 = 218 * MiB, WS_SS1 = 224 * MiB, WS_SSL = 230 * MiB;
constexpr size_t WS_PB = 236 * MiB;
constexpr size_t WS_TR = 284 * MiB;
constexpr size_t WS_XB2 = WS_TR;
constexpr size_t WS_H = WS_TR;
constexpr size_t WS_PROJ = 812 * MiB;
constexpr size_t WS_QKV = 476 * MiB;
constexpr size_t WS_VTA = 764 * MiB;
constexpr size_t WS_LQ = 476 * MiB, WS_LKV = 548 * MiB, WS_KR = 572 * MiB;
constexpr size_t WS_Q = WS_TR;
constexpr size_t WS_KV = 584 * MiB;
constexpr size_t WS_K = 776 * MiB;
constexpr size_t WS_VTB = 920 * MiB;
constexpr size_t WS_END = 1016 * MiB;
constexpr size_t WS_BAR = WS_END, WS_BAR_BYTES = 16384, WS_TOTAL = WS_BAR + WS_BAR_BYTES;
static_assert(XCD_BAR_WORDS * 4 <= WS_BAR_BYTES, "barrier words");
static_assert(WS_H + (size_t)TT * FFH * 2 <= WS_PROJ && WS_PROJ + (size_t)TT * DM * 2 <= WS_END, "ffn map");
static_assert(WS_XB2 + (size_t)TT * DM * 2 <= WS_QKV && WS_QKV + (size_t)TT * 1536 * 2 <= WS_VTA && WS_VTA + (size_t)TT * 256 * 2 <= WS_PROJ, "mixer A map");
static_assert(WS_LQ + (size_t)TT * 384 * 2 <= WS_LKV && WS_LKV + (size_t)TT * 128 * 2 <= WS_KR && WS_KR + (size_t)TT * 32 * 4 <= WS_KV, "mixer B map 1");
static_assert(WS_Q + (size_t)TH * 1536 * 2 <= WS_LQ && WS_KV + (size_t)TH * 2048 * 2 <= WS_K && WS_K + (size_t)TH * 1536 * 2 <= WS_VTB && WS_VTB + (size_t)TH * 1024 * 2 <= WS_END, "mixer B map 2");
static_assert(WS_XB + (size_t)TT * DM * 2 <= WS_SS0 && WS_PB + (size_t)TT * PLE * 2 <= WS_TR, "fixed map");
constexpr size_t WE = 1u << 20;
constexpr size_t WO_MIX = 0, WO_MIX_O_A = WE * 3 / 2;
constexpr size_t WO_B_UQ = WE * 3 / 4, WO_B_UKV = WE * 21 / 16, WO_B_O = WE * 25 / 16;
constexpr size_t WO_GU = 3 * WE, WO_D = WE * 17 / 2, WO_PG = WE * 45 / 4, WO_PP = WE * 49 / 4, WO_END = WE * 25 / 2;
static_assert(WO_B_UQ == 768u * 1024 && WO_B_UKV == WO_B_UQ + 1536u * 384 && WO_B_O == WO_B_UKV + 2048u * 128 && WO_B_O + WE <= WO_GU, "weight map B");
static_assert(WO_D == WO_GU + 5632u * 1024 && WO_PG == WO_D + 1024u * 2816 && WO_PP == WO_PG + WE && WO_END == WO_PP + 1024u * 256 && WO_END * 2 <= 25 * MiB, "weight map");

constexpr int LDS_BYTES = 131072 + 1024;
__constant__ float INV_FREQ[16] = {1.000000000e+00f, 4.403666258e-01f, 1.939227581e-01f, 8.539710194e-02f, 3.760603070e-02f, 1.656044088e-02f, 7.292665076e-03f, 3.211446106e-03f,
                                   1.414213446e-03f, 6.227724371e-04f, 2.742481884e-04f, 1.207697424e-04f, 5.318296462e-05f, 2.341999789e-05f, 1.031338525e-05f, 4.541670478e-06f};

__device__ __forceinline__ float wave_sum(float v) {
#pragma unroll
    for (int o = 1; o < 64; o <<= 1) v += __shfl_xor(v, o);
    return v;
}
__device__ __forceinline__ void unpack8(const u32x4 w, float* v) { v[0] = bf_lo(w.x); v[1] = bf_hi(w.x); v[2] = bf_lo(w.y); v[3] = bf_hi(w.y); v[4] = bf_lo(w.z); v[5] = bf_hi(w.z); v[6] = bf_lo(w.w); v[7] = bf_hi(w.w); }
__device__ __forceinline__ u32x4 pack8(const float* v) { u32x4 w; w.x = cvt_pk_bf16(v[0], v[1]); w.y = cvt_pk_bf16(v[2], v[3]); w.z = cvt_pk_bf16(v[4], v[5]); w.w = cvt_pk_bf16(v[6], v[7]); return w; }

__device__ __forceinline__ void cvt_item(const float* W, int K, int Nsrc, int Ndst, int mode, const float* gain, bf16_t* dst, LAS float* scr, int it, int lane) {
    const int nblk = Ndst / 32;
    const int kb = it / nblk, nb = it % nblk, k0 = 64 * kb, n0 = 32 * nb;
    int src0;
    if (mode == 1) { const int tile = nb >> 3, w = nb & 7; src0 = (w >> 2) * FFH + tile * 128 + (w & 3) * 32; }
    else src0 = (n0 < Nsrc) ? n0 : -1;
#pragma unroll 8
    for (int i = 0; i < 32; ++i) { const int kk = 2 * i + (lane >> 5); float v = src0 >= 0 ? W[(size_t)(k0 + kk) * Nsrc + src0 + (lane & 31)] : 0.f; if (gain) v *= gain[k0 + kk]; scr[kk * 33 + (lane & 31)] = v; }
    asm volatile("s_waitcnt lgkmcnt(0)" ::: "memory");
    const int c = lane & 7;
#pragma unroll
    for (int j = 0; j < 4; ++j) { const int n = (lane >> 3) + 8 * j; const LAS float* s = scr + (8 * c) * 33 + n;
        u32x4 o; o.x = cvt_pk_bf16(s[0 * 33], s[1 * 33]); o.y = cvt_pk_bf16(s[2 * 33], s[3 * 33]); o.z = cvt_pk_bf16(s[4 * 33], s[5 * 33]); o.w = cvt_pk_bf16(s[6 * 33], s[7 * 33]);
        *(u32x4*)(dst + (size_t)(n0 + n) * K + k0 + 8 * c) = o; }
    asm volatile("s_waitcnt lgkmcnt(0)" ::: "memory");
}
struct Args { const float* in[24]; float* out; unsigned char* ws; int ph_lo, ph_hi; };
__device__ __forceinline__ void cvt_layer(const Args& a, int L, bf16_t* WLp, LAS float* scr, int gw, int NGW, int part  ) {
    int tl = threadIdx.x; asm volatile("" : "+v"(tl)); const int lane = tl & 63;
    const int j = L >> 1; const bool isA = (L & 1) == 0;
    const int n0 = isA ? 768 : 384, n1 = isA ? 512 : 288, n2 = isA ? 0 : 128, n3 = isA ? 0 : 512;
    const int total = n0 + n1 + n2 + n3 + 2816 + 1408 + 512 + 128;
    const int nm = n0 + n1 + n2 + n3; const int it_lo = (part & 1) ? 0 : ((part & 2) ? nm : nm + 4224), it_hi = (part & 4) ? total : ((part & 2) ? nm + 4224 : nm);
    for (int it = it_lo + gw; it < it_hi; it += NGW) {
        int r = it; const float* W; int K, Nsrc, Ndst, mode = 0; const float* gain = nullptr; size_t doff;
        if (r < n0) { if (isA) { W = a.in[5] + (size_t)j * 1024 * 1536; K = 1024; Nsrc = 1536; Ndst = 1536; } else { W = a.in[10] + (size_t)j * 1024 * 544; K = 1024; Nsrc = 544; Ndst = 768; } gain = a.in[4] + L * 1024; doff = WO_MIX; }
        else if ((r -= n0) < n1) { if (isA) { W = a.in[9] + (size_t)j * 1024 * 1024; K = 1024; Nsrc = 1024; Ndst = 1024; doff = WO_MIX_O_A; } else { W = a.in[13] + (size_t)j * 384 * 1536; K = 384; Nsrc = 1536; Ndst = 1536; gain = a.in[11] + j * 384; doff = WO_B_UQ; } }
        else if ((r -= n1) < n2) { W = a.in[14] + (size_t)j * 128 * 2048; K = 128; Nsrc = 2048; Ndst = 2048; gain = a.in[12] + j * 128; doff = WO_B_UKV; }
        else if ((r -= n2) < n3) { W = a.in[17] + (size_t)j * 1024 * 1024; K = 1024; Nsrc = 1024; Ndst = 1024; doff = WO_B_O; }
        else if ((r -= n3) < 2816) { W = a.in[19] + (size_t)L * 1024 * 5632; K = 1024; Nsrc = 5632; Ndst = 5632; mode = 1; gain = a.in[18] + L * 1024; doff = WO_GU; }
        else if ((r -= 2816) < 1408) { W = a.in[20] + (size_t)L * 2816 * 1024; K = 2816; Nsrc = 1024; Ndst = 1024; doff = WO_D; }
        else if ((r -= 1408) < 512) { W = a.in[22] + (size_t)L * 1024 * 1024; K = 1024; Nsrc = 1024; Ndst = 1024; gain = a.in[21] + L * 1024; doff = WO_PG; }
        else { r -= 512; W = a.in[23] + (size_t)L * 256 * 1024; K = 256; Nsrc = 1024; Ndst = 1024; doff = WO_PP; }
        cvt_item(W, K, Nsrc, Ndst, mode, gain, WLp + doff, scr, r, lane);
    }
}

__device__ __forceinline__ int crow(int r, int hi) { return (r & 3) + 8 * (r >> 2) + 4 * hi; }
typedef float f32x2_t __attribute__((ext_vector_type(2))); typedef __bf16 bf16x2_t __attribute__((ext_vector_type(2)));
__device__ __forceinline__ float max3f(float a, float b, float c) { float r; asm("v_max3_f32 %0, %1, %2, %3" : "=v"(r) : "v"(a), "v"(b), "v"(c)); return r; }
__device__ __forceinline__ unsigned cvtpk_s(float lo, float hi) { f32x2_t v = {lo, hi}; bf16x2_t b = __builtin_convertvector(v, bf16x2_t); return __builtin_bit_cast(unsigned, b); }
template <int DQK, bool WIN>
__device__ __forceinline__ void attn_unit(LAS unsigned char* lds, const bf16_t* qrow, bf16_t* orow, const bf16_t* Kb, int ldk, const bf16_t* Vtb, int ldv,
                                          int kt0, int kt1, int qpos, float m_init, float l_init, const float* qg = nullptr, const f32x2* rope = nullptr) {
    constexpr int KP = DQK + 8, VP = 72, KBUF = 64 * KP * 2, VBUF = 64 * VP * 2, CPR = DQK / 8, NCH = 64 * CPR, ND = DQK / 16;
    constexpr float THR = 8.f;
    int tid_l = threadIdx.x; asm volatile("" : "+v"(tid_l));
    const int tid = tid_l, lane = tid & 63, r32 = lane & 31, hi = lane >> 5;
    LAS unsigned char* Kl = lds; LAS unsigned char* Vl = lds + 2 * KBUF;
    bf16x8 qf[ND];
#pragma unroll
    for (int d0 = 0; d0 < ND; ++d0) qf[d0] = *(const bf16x8*)(qrow + d0 * 16 + hi * 8);
    if (!WIN && qg) {
        float a[ND][8]; float ss = 0.f;
#pragma unroll
        for (int d0 = 0; d0 < ND; ++d0) { unpack8(__builtin_bit_cast(u32x4, qf[d0]), a[d0]);
#pragma unroll
            for (int e = 0; e < 8; ++e) ss += a[d0][e] * a[d0][e]; }
        ss += __shfl_xor(ss, 32);
        const float rs = __builtin_amdgcn_rsqf(ss * (1.f / 96.f) + EPS), qs = 0.10206207261596575f * LOG2E;
#pragma unroll
        for (int d0 = 0; d0 < ND; ++d0) { const f32x4 g0 = *(const f32x4*)(qg + d0 * 16 + hi * 8), g1 = *(const f32x4*)(qg + d0 * 16 + hi * 8 + 4);
#pragma unroll
            for (int e = 0; e < 4; ++e) { a[d0][e] *= rs * g0[e]; a[d0][4 + e] *= rs * g1[e]; } }
#pragma unroll
        for (int e = 0; e < 8; ++e) { const f32x2 cs = rope[qpos * 16 + 8 * hi + e]; const float x1 = a[4][e], x2 = a[5][e]; a[4][e] = x1 * cs.x - x2 * cs.y; a[5][e] = x1 * cs.y + x2 * cs.x; }
#pragma unroll
        for (int d0 = 0; d0 < ND; ++d0) {
#pragma unroll
            for (int e = 0; e < 8; ++e) a[d0][e] *= qs;
            qf[d0] = __builtin_bit_cast(bf16x8, pack8(a[d0])); }
    }
    f32x16 o0, o1, negm;
#pragma unroll
    for (int r = 0; r < 16; ++r) { o0[r] = 0.f; o1[r] = 0.f; negm[r] = -m_init; }
    float m = m_init, l = hi == 0 ? l_init : 0.f;
    u32x4 kxa0, kxa1, vxa, kxb0, kxb1, vxb;
    const int c1 = (tid + 512) < NCH ? tid + 512 : tid;
    const int kr0 = tid / CPR, kc0 = tid % CPR, kr1 = c1 / CPR, kc1 = c1 % CPR;
    const int vd = tid >> 3, vcc = tid & 7;
    const int n = kt1 - kt0;
#define ATT_LOADK(K0_, K1_, t) do { K0_ = *(const u32x4*)(Kb + (size_t)(64 * (t) + kr0) * ldk + kc0 * 8); if (NCH > 512) K1_ = *(const u32x4*)(Kb + (size_t)(64 * (t) + kr1) * ldk + kc1 * 8); } while (0)
#define ATT_LOADV(V_, t) do { V_ = *(const u32x4*)(Vtb + (size_t)vd * ldv + 64 * (t) + vcc * 8); } while (0)
#define ATT_STOREK(K0_, K1_, b) do { *(LAS u32x4*)(Kl + (b) * KBUF + kr0 * (KP * 2) + kc0 * 16) = K0_; if (NCH > 512) *(LAS u32x4*)(Kl + (b) * KBUF + kr1 * (KP * 2) + kc1 * 16) = K1_; } while (0)
#define ATT_STOREV(V_, b) do { *(LAS u32x4*)(Vl + (b) * VBUF + vd * (VP * 2) + vcc * 16) = V_; } while (0)
#define ATT_BAR() do { asm volatile("s_waitcnt lgkmcnt(0)" ::: "memory"); __builtin_amdgcn_s_barrier(); asm volatile("" ::: "memory"); } while (0)
#define ATT_QK(S0, S1, b) do { const LAS unsigned char* kp_ = Kl + (b) * KBUF + r32 * (KP * 2) + hi * 16; \
        _Pragma("unroll") for (int d0 = 0; d0 < ND; ++d0) { const bf16x8 k0_ = *(const LAS bf16x8*)(kp_ + d0 * 32); const bf16x8 k1_ = *(const LAS bf16x8*)(kp_ + 32 * KP * 2 + d0 * 32); \
            if (d0 == 0) { S0 = __builtin_amdgcn_mfma_f32_32x32x16_bf16(k0_, qf[0], negm, 0, 0, 0); S1 = __builtin_amdgcn_mfma_f32_32x32x16_bf16(k1_, qf[0], negm, 0, 0, 0); } \
            else { S0 = __builtin_amdgcn_mfma_f32_32x32x16_bf16(k0_, qf[d0], S0, 0, 0, 0); S1 = __builtin_amdgcn_mfma_f32_32x32x16_bf16(k1_, qf[d0], S1, 0, 0, 0); } } } while (0)
#define SB_() __builtin_amdgcn_sched_barrier(0)
#define ATT_MAXP(S0, S1, MXV) do { float mx2_ = __builtin_fmaxf(S0[0], S1[0]); \
        _Pragma("unroll") for (int r = 1; r < 16; ++r) mx2_ = __builtin_fmaxf(mx2_, __builtin_fmaxf(S0[r], S1[r])); MXV = mx2_; } while (0)
#define ATT_EXP(idx_, C0, C1) do { if ((idx_) < 16) { C0[(idx_) & 15] = __builtin_amdgcn_exp2f(C0[(idx_) & 15]); ls_ += C0[(idx_) & 15]; } else { C1[(idx_) & 15] = __builtin_amdgcn_exp2f(C1[(idx_) & 15]); ls_ += C1[(idx_) & 15]; } } while (0)
#define ATT_STEP(i_, C0, C1, N0, N1, LK0, LK1, LV, SK0, SK1, SV) do { const int ii_ = (i_); const int b_ = ii_ & 1; constexpr int NG_ = 2 * ND, EQ_ = 24 / NG_; \
        { const int tk_ = (kt0 + ii_ + 3) < kt1 ? (kt0 + ii_ + 3) : (kt1 - 1), tv_ = (kt0 + ii_ + 2) < kt1 ? (kt0 + ii_ + 2) : (kt1 - 1); ATT_LOADK(LK0, LK1, tk_); ATT_LOADV(LV, tv_); } \
        bf16x8 kf_[NG_]; \
        { const LAS unsigned char* kp_ = Kl + (b_ ^ 1) * KBUF + r32 * (KP * 2) + hi * 16; \
          _Pragma("unroll") for (int g = 0; g < ND; ++g) kf_[g] = *(const LAS bf16x8*)(kp_ + (g & 1) * (32 * KP * 2) + (g >> 1) * 32); } \
        SB_(); \
        if (WIN) { const int kb_ = 64 * (kt0 + ii_) + 4 * hi - qpos; \
            _Pragma("unroll") for (int r = 0; r < 16; ++r) { const int dk_ = kb_ + (r & 3) + 8 * (r >> 2); if (dk_ > 128 || dk_ < -128) C0[r] = -1e30f; if (dk_ + 32 > 128 || dk_ + 32 < -128) C1[r] = -1e30f; } \
            ATT_MAXP(C0, C1, mxc); } \
        float mx_; { auto rr_ = __builtin_amdgcn_permlane32_swap(__float_as_uint(mxc), __float_as_uint(mxc), false, false); mx_ = fmaxf(__uint_as_float(rr_[0]), __uint_as_float(rr_[1])); } \
        const bool first_ = !WIN && ii_ == 0; \
        if (first_ || __any(mx_ > THR)) { const float d_ = first_ ? mx_ : fmaxf(mx_, 0.f); m += d_; const float al_ = __builtin_amdgcn_exp2f(-d_); l *= al_; \
            _Pragma("unroll") for (int r = 0; r < 16; ++r) { C0[r] -= d_; C1[r] -= d_; o0[r] *= al_; o1[r] *= al_; negm[r] = -m; } } \
        SB_(); \
        float ls_ = 0.f; bf16x8 vf_[8]; \
        const LAS unsigned char* vp_ = Vl + b_ * VBUF + r32 * (VP * 2) + hi * 16; \
        _Pragma("unroll") for (int g = 0; g < NG_; ++g) { \
            if ((g & 1) == 0) { if (g == 0) N0 = __builtin_amdgcn_mfma_f32_32x32x16_bf16(kf_[0], qf[0], negm, 0, 0, 0); else N0 = __builtin_amdgcn_mfma_f32_32x32x16_bf16(kf_[g], qf[g >> 1], N0, 0, 0, 0); } \
            else { if (g == 1) N1 = __builtin_amdgcn_mfma_f32_32x32x16_bf16(kf_[1], qf[0], negm, 0, 0, 0); else N1 = __builtin_amdgcn_mfma_f32_32x32x16_bf16(kf_[g], qf[g >> 1], N1, 0, 0, 0); } \
            if (g < ND) { const LAS unsigned char* kp_ = Kl + (b_ ^ 1) * KBUF + r32 * (KP * 2) + hi * 16; kf_[g + ND] = *(const LAS bf16x8*)(kp_ + ((g + ND) & 1) * (32 * KP * 2) + ((g + ND) >> 1) * 32); } \
            if (g >= NG_ - 4) { const int f = g - (NG_ - 4); vf_[f] = *(const LAS bf16x8*)(vp_ + (f & 1) * (32 * VP * 2) + (f >> 1) * 32); } \
            _Pragma("unroll") for (int e = 0; e < EQ_; ++e) ATT_EXP(g * EQ_ + e, C0, C1); \
            SB_(); } \
        u32x4 pw_[4]; \
        pw_[0].x = cvtpk_s(C0[0], C0[1]); pw_[0].y = cvtpk_s(C0[2], C0[3]); pw_[0].z = cvtpk_s(C0[4], C0[5]); pw_[0].w = cvtpk_s(C0[6], C0[7]); \
        SB_(); \
        float mxa_ = 0.f, mxb_ = 0.f; \
        o0 = __builtin_amdgcn_mfma_f32_32x32x16_bf16(vf_[0], __builtin_bit_cast(bf16x8, pw_[0]), o0, 0, 0, 0); \
        pw_[1].x = cvtpk_s(C0[8], C0[9]); pw_[1].y = cvtpk_s(C0[10], C0[11]); ATT_EXP(24, C0, C1); ATT_EXP(25, C0, C1); \
        vf_[4] = *(const LAS bf16x8*)(vp_ + 64); vf_[5] = *(const LAS bf16x8*)(vp_ + (32 * VP * 2) + 64); \
        SB_(); \
        o1 = __builtin_amdgcn_mfma_f32_32x32x16_bf16(vf_[1], __builtin_bit_cast(bf16x8, pw_[0]), o1, 0, 0, 0); \
        pw_[1].z = cvtpk_s(C0[12], C0[13]); pw_[1].w = cvtpk_s(C0[14], C0[15]); ATT_EXP(26, C0, C1); ATT_EXP(27, C0, C1); \
        vf_[6] = *(const LAS bf16x8*)(vp_ + 96); vf_[7] = *(const LAS bf16x8*)(vp_ + (32 * VP * 2) + 96); \
        SB_(); \
        o0 = __builtin_amdgcn_mfma_f32_32x32x16_bf16(vf_[2], __builtin_bit_cast(bf16x8, pw_[1]), o0, 0, 0, 0); \
        pw_[2].x = cvtpk_s(C1[0], C1[1]); pw_[2].y = cvtpk_s(C1[2], C1[3]); ATT_EXP(28, C0, C1); ATT_EXP(29, C0, C1); \
        SB_(); \
        o1 = __builtin_amdgcn_mfma_f32_32x32x16_bf16(vf_[3], __builtin_bit_cast(bf16x8, pw_[1]), o1, 0, 0, 0); \
        pw_[2].z = cvtpk_s(C1[4], C1[5]); pw_[2].w = cvtpk_s(C1[6], C1[7]); ATT_EXP(30, C0, C1); ATT_EXP(31, C0, C1); \
        SB_(); \
        o0 = __builtin_amdgcn_mfma_f32_32x32x16_bf16(vf_[4], __builtin_bit_cast(bf16x8, pw_[2]), o0, 0, 0, 0); \
        pw_[3].x = cvtpk_s(C1[8], C1[9]); pw_[3].y = cvtpk_s(C1[10], C1[11]); \
        if (!WIN) { mxa_ = max3f(N0[0], N1[0], N0[1]); mxb_ = max3f(N1[1], N0[2], N1[2]); mxa_ = max3f(mxa_, N0[3], N1[3]); mxb_ = max3f(mxb_, N0[4], N1[4]); } \
        SB_(); \
        o1 = __builtin_amdgcn_mfma_f32_32x32x16_bf16(vf_[5], __builtin_bit_cast(bf16x8, pw_[2]), o1, 0, 0, 0); \
        pw_[3].z = cvtpk_s(C1[12], C1[13]); pw_[3].w = cvtpk_s(C1[14], C1[15]); \
        if (!WIN) { mxa_ = max3f(mxa_, N0[5], N1[5]); mxb_ = max3f(mxb_, N0[6], N1[6]); mxa_ = max3f(mxa_, N0[7], N1[7]); mxb_ = max3f(mxb_, N0[8], N1[8]); } \
        SB_(); \
        o0 = __builtin_amdgcn_mfma_f32_32x32x16_bf16(vf_[6], __builtin_bit_cast(bf16x8, pw_[3]), o0, 0, 0, 0); \
        if (!WIN) { mxa_ = max3f(mxa_, N0[9], N1[9]); mxb_ = max3f(mxb_, N0[10], N1[10]); mxa_ = max3f(mxa_, N0[11], N1[11]); mxb_ = max3f(mxb_, N0[12], N1[12]); } \
        SB_(); \
        o1 = __builtin_amdgcn_mfma_f32_32x32x16_bf16(vf_[7], __builtin_bit_cast(bf16x8, pw_[3]), o1, 0, 0, 0); \
        if (!WIN) { mxa_ = max3f(mxa_, N0[13], N1[13]); mxb_ = max3f(mxb_, N0[14], N1[14]); mxa_ = max3f(mxa_, N0[15], N1[15]); mxc = fmaxf(mxa_, mxb_); } \
        l += ls_; \
        SB_(); \
        ATT_STOREV(SV, b_ ^ 1); ATT_STOREK(SK0, SK1, b_); \
        ATT_BAR(); } while (0)
    {
        u32x4 kt0_ = {0u, 0u, 0u, 0u}, kt1r_ = {0u, 0u, 0u, 0u};
        const int t1_ = (kt0 + 1) < kt1 ? (kt0 + 1) : (kt1 - 1), t2_ = (kt0 + 2) < kt1 ? (kt0 + 2) : (kt1 - 1);
        ATT_LOADK(kxa0, kxa1, kt0); ATT_LOADV(vxa, kt0); ATT_LOADK(kt0_, kt1r_, t1_); ATT_LOADK(kxb0, kxb1, t2_); ATT_LOADV(vxb, t1_);
        ATT_STOREK(kxa0, kxa1, 0); ATT_STOREV(vxa, 0); ATT_STOREK(kt0_, kt1r_, 1);
    }
    ATT_BAR();
    f32x16 sa0, sa1, sb0, sb1; float mxc = 0.f;
    ATT_QK(sa0, sa1, 0);
    if (!WIN) ATT_MAXP(sa0, sa1, mxc);
    ATT_BAR();
    if (tid >= 256) __builtin_amdgcn_s_setprio(1);
    int it = 0;
    for (; it + 1 < n; it += 2) { ATT_STEP(it, sa0, sa1, sb0, sb1, kxa0, kxa1, vxa, kxb0, kxb1, vxb); ATT_STEP(it + 1, sb0, sb1, sa0, sa1, kxb0, kxb1, vxb, kxa0, kxa1, vxa); }
    if (it < n) ATT_STEP(it, sa0, sa1, sb0, sb1, kxa0, kxa1, vxa, kxb0, kxb1, vxb);
    __builtin_amdgcn_s_setprio(0);
    asm volatile("s_waitcnt vmcnt(0)" ::: "memory");
#undef ATT_LOADK
#undef ATT_LOADV
#undef ATT_STOREK
#undef ATT_STOREV
#undef ATT_QK
#undef ATT_STEP
#undef ATT_MAXP
#undef ATT_EXP
#undef SB_
#undef ATT_BAR
    l += __shfl_xor(l, 32); const float rl = 1.f / l;
#pragma unroll
    for (int g = 0; g < 4; ++g) { u32x2 w; w.x = cvt_pk_bf16(o0[4 * g] * rl, o0[4 * g + 1] * rl); w.y = cvt_pk_bf16(o0[4 * g + 2] * rl, o0[4 * g + 3] * rl); *(u32x2*)(orow + 8 * g + 4 * hi) = w;
        w.x = cvt_pk_bf16(o1[4 * g] * rl, o1[4 * g + 1] * rl); w.y = cvt_pk_bf16(o1[4 * g + 2] * rl, o1[4 * g + 3] * rl); *(u32x2*)(orow + 32 + 8 * g + 4 * hi) = w; }
}

__device__ __forceinline__ void win_unit(LAS unsigned char* lds, bf16_t* QKV, const bf16_t* VTA, int st, int S, int nblk, int kvh, const float* sink) {
    constexpr int RP = 144, TB = 64 * RP;
    int tid_l = threadIdx.x; asm volatile("" : "+v"(tid_l));
    const int tid = tid_l, lane = tid & 63, r32 = lane & 31, hi = lane >> 5, wid = __builtin_amdgcn_readfirstlane(tid >> 6);
    const int nt_all = S >> 6, kt0 = (2 * nblk - 2) > 0 ? (2 * nblk - 2) : 0, kt1 = (2 * nblk + 4) < nt_all ? (2 * nblk + 4) : nt_all, nt = kt1 - kt0;
    LAS unsigned char* Kl = lds; LAS unsigned char* Vl = lds + 6 * TB;
    const bf16_t* Kb = QKV + (size_t)st * 1536 + 1024 + kvh * 64; const bf16_t* Vtb = VTA + (size_t)st * 256 + (size_t)kvh * 64 * S;
    { const int kr = tid >> 3, kc = tid & 7; u32x4 kreg[6], vreg[6];
#pragma unroll
      for (int t = 0; t < 6; ++t) if (t < nt) { kreg[t] = *(const u32x4*)(Kb + (size_t)(64 * (kt0 + t) + kr) * 1536 + kc * 8); vreg[t] = *(const u32x4*)(Vtb + (size_t)kr * S + 64 * (kt0 + t) + kc * 8); }
#pragma unroll
      for (int t = 0; t < 6; ++t) if (t < nt) { *(LAS u32x4*)(Kl + t * TB + kr * RP + kc * 16) = kreg[t]; *(LAS u32x4*)(Vl + t * TB + kr * RP + kc * 16) = vreg[t]; } }
    __syncthreads();
    for (int p = 0; p < 2; ++p) {
        const int head = kvh * 4 + 2 * p + (wid >> 2), wq0 = nblk * 128 + (wid & 3) * 32, qpos = wq0 + r32;
        bf16_t* qrow = QKV + (size_t)(st + qpos) * 1536 + head * 64;
        bf16x8 qf[4];
#pragma unroll
        for (int d0 = 0; d0 < 4; ++d0) qf[d0] = *(const bf16x8*)(qrow + d0 * 16 + hi * 8);
        f32x16 o0, o1;
#pragma unroll
        for (int r = 0; r < 16; ++r) { o0[r] = 0.f; o1[r] = 0.f; }
        float m = sink[head] * LOG2E, l = hi == 0 ? 1.f : 0.f;
        for (int t = 0; t < nt; ++t) {
            const int k0pos = 64 * (kt0 + t);
            if (k0pos > wq0 + 159 || k0pos + 63 < wq0 - 128) continue;
            f32x16 s0, s1;
#pragma unroll
            for (int r = 0; r < 16; ++r) { s0[r] = 0.f; s1[r] = 0.f; }
            const LAS unsigned char* kp = Kl + t * TB + r32 * RP + hi * 16;
#pragma unroll
            for (int d0 = 0; d0 < 4; ++d0) { const bf16x8 k0 = *(const LAS bf16x8*)(kp + d0 * 32); const bf16x8 k1 = *(const LAS bf16x8*)(kp + 32 * RP + d0 * 32);
                s0 = __builtin_amdgcn_mfma_f32_32x32x16_bf16(k0, qf[d0], s0, 0, 0, 0); s1 = __builtin_amdgcn_mfma_f32_32x32x16_bf16(k1, qf[d0], s1, 0, 0, 0); }
            { const int kb = k0pos + 4 * hi - qpos;
#pragma unroll
              for (int r = 0; r < 16; ++r) { const int dk = kb + (r & 3) + 8 * (r >> 2); if (dk > 128 || dk < -128) s0[r] = -1e30f; if (dk + 32 > 128 || dk + 32 < -128) s1[r] = -1e30f; } }
            float mx = __builtin_fmaxf(s0[0], s1[0]);
#pragma unroll
            for (int r = 1; r < 16; ++r) mx = __builtin_fmaxf(mx, __builtin_fmaxf(s0[r], s1[r]));
            mx = __builtin_fmaxf(mx, __shfl_xor(mx, 32));
            const float mn = __builtin_fmaxf(m, mx), alpha = __builtin_amdgcn_exp2f(m - mn); m = mn;
            float ls = 0.f;
#pragma unroll
            for (int r = 0; r < 16; ++r) { s0[r] = __builtin_amdgcn_exp2f(s0[r] - mn); s1[r] = __builtin_amdgcn_exp2f(s1[r] - mn); ls += s0[r] + s1[r]; }
            l = l * alpha + ls;
#pragma unroll
            for (int r = 0; r < 16; ++r) { o0[r] *= alpha; o1[r] *= alpha; }
            u32x4 pw[4];
#pragma unroll
            for (int c = 0; c < 2; ++c) { pw[c].x = cvtpk_s(s0[8 * c], s0[8 * c + 1]); pw[c].y = cvtpk_s(s0[8 * c + 2], s0[8 * c + 3]); pw[c].z = cvtpk_s(s0[8 * c + 4], s0[8 * c + 5]); pw[c].w = cvtpk_s(s0[8 * c + 6], s0[8 * c + 7]);
                pw[2 + c].x = cvtpk_s(s1[8 * c], s1[8 * c + 1]); pw[2 + c].y = cvtpk_s(s1[8 * c + 2], s1[8 * c + 3]); pw[2 + c].z = cvtpk_s(s1[8 * c + 4], s1[8 * c + 5]); pw[2 + c].w = cvtpk_s(s1[8 * c + 6], s1[8 * c + 7]); }
            const LAS unsigned char* vp = Vl + t * TB + r32 * RP + hi * 16;
#pragma unroll
            for (int j = 0; j < 4; ++j) { const bf16x8 v0 = *(const LAS bf16x8*)(vp + j * 32); const bf16x8 v1 = *(const LAS bf16x8*)(vp + 32 * RP + j * 32);
                o0 = __builtin_amdgcn_mfma_f32_32x32x16_bf16(v0, __builtin_bit_cast(bf16x8, pw[j]), o0, 0, 0, 0); o1 = __builtin_amdgcn_mfma_f32_32x32x16_bf16(v1, __builtin_bit_cast(bf16x8, pw[j]), o1, 0, 0, 0); }
        }
        l += __shfl_xor(l, 32); const float rl = 1.f / l;
#pragma unroll
        for (int g = 0; g < 4; ++g) { u32x2 w; w.x = cvt_pk_bf16(o0[4 * g] * rl, o0[4 * g + 1] * rl); w.y = cvt_pk_bf16(o0[4 * g + 2] * rl, o0[4 * g + 3] * rl); *(u32x2*)(qrow + 8 * g + 4 * hi) = w;
            w.x = cvt_pk_bf16(o1[4 * g] * rl, o1[4 * g + 1] * rl); w.y = cvt_pk_bf16(o1[4 * g + 2] * rl, o1[4 * g + 3] * rl); *(u32x2*)(qrow + 32 + 8 * g + 4 * hi) = w; }
    }
    __syncthreads();
}

__device__ __forceinline__ void pb_chunk(const float* pp, const float* ps, int layer, bf16_t* PB, int tok0, int tid) {
    f32x4 v[8];
#pragma unroll
    for (int k = 0; k < 8; ++k) { const int idx4 = tid + 512 * k, tok = tok0 + (idx4 >> 6), c4 = idx4 & 63; const int e = ext_row(tok);
        const float* src = e < 65536 ? pp + ((size_t)layer * 65536 + e) * PLE : ps + ((size_t)layer * 32768 + (e - 65536)) * PLE;
        v[k] = *(const f32x4*)(src + c4 * 4); }
#pragma unroll
    for (int k = 0; k < 8; ++k) { const int idx4 = tid + 512 * k, tok = tok0 + (idx4 >> 6), c4 = idx4 & 63;
        u32x2 w; w.x = cvt_pk_bf16(v[k][0], v[k][1]); w.y = cvt_pk_bf16(v[k][2], v[k][3]); *(u32x2*)(PB + (size_t)tok * PLE + c4 * 4) = w; }
}
__device__ __forceinline__ void fixup_a(LAS unsigned char* lds, bf16_t* QKV, bf16_t* VtA, const float* qg, const float* kg, const f32x2* rope, int vcu, int G,
                                        const float* pp, const float* ps, int layer, bf16_t* PB) {
    int tid_l = threadIdx.x; asm volatile("" : "+v"(tid_l));
    const int tid = tid_l, lane = tid & 63, wid = tid >> 6, sub = lane & 7, hl = lane >> 3;
    LAS bf16_t* vt = (LAS bf16_t*)lds;
    for (int chunk = vcu; chunk < TT / 64; chunk += G) {
        const int tok0 = chunk * 64; int st, S; seq_of(tok0, st, S);
        for (int ib = 0; ib < 2; ++ib) {
            u32x4 rawb[4][3]; f32x2 csb[4][8];
#pragma unroll
            for (int t = 0; t < 4; ++t) { const int tok = tok0 + wid * 8 + ib * 4 + t, pos = tok - st; const bf16_t* rowp = QKV + (size_t)tok * 1536;
#pragma unroll
                for (int rr = 0; rr < 3; ++rr) rawb[t][rr] = *(const u32x4*)(rowp + (rr * 8 + hl) * 64 + sub * 8);
#pragma unroll
                for (int e = 0; e < 8; ++e) csb[t][e] = rope[pos * 16 + 2 * e]; }
#pragma unroll
            for (int t = 0; t < 4; ++t) { const int i = ib * 4 + t; const int tok = tok0 + wid * 8 + i; bf16_t* rowp = QKV + (size_t)tok * 1536;
#pragma unroll
                for (int rr = 0; rr < 3; ++rr) { const int hh = rr * 8 + hl; const u32x4 raw = rawb[t][rr];
                    float v[8]; unpack8(raw, v);
                    float ss = 0.f;
#pragma unroll
                    for (int e = 0; e < 8; ++e) ss += v[e] * v[e];
                    ss += __shfl_xor(ss, 1); ss += __shfl_xor(ss, 2); ss += __shfl_xor(ss, 4);
                    const float rs = __builtin_amdgcn_rsqf(ss * (1.f / 64.f) + EPS);
                    const float* g = hh < 16 ? qg : kg;
                    float pv[8];
#pragma unroll
                    for (int e = 0; e < 8; ++e) { v[e] = v[e] * rs * g[sub * 8 + e]; pv[e] = __shfl_xor(v[e], 1); }
                    if (sub < 2) {
#pragma unroll
                        for (int e = 0; e < 8; ++e) { const f32x2 cs = csb[t][e]; v[e] = sub == 0 ? v[e] * cs.x - pv[e] * cs.y : pv[e] * cs.y + v[e] * cs.x; } }
                    if (hh < 16) {
#pragma unroll
                        for (int e = 0; e < 8; ++e) v[e] *= 0.125f * LOG2E; }
                    if (hh < 20) *(u32x4*)(rowp + hh * 64 + sub * 8) = pack8(v);
                    else { const int hv = hh - 20; const unsigned w[4] = {raw.x, raw.y, raw.z, raw.w};
#pragma unroll
                        for (int e = 0; e < 8; ++e) vt[(hv * 64 + sub * 8 + e) * 72 + wid * 8 + i] = (bf16_t)((e & 1) ? (w[e >> 1] >> 16) : (w[e >> 1] & 0xffffu)); } } } }
        __syncthreads();
#pragma unroll
        for (int k = 0; k < 4; ++k) { const int c = tid + 512 * k, row = c >> 3, cc = c & 7, hv = row >> 6, d = row & 63;
            const u32x2 d0_ = *(const LAS u32x2*)(vt + row * 72 + (cc >> 1) * 16 + (cc & 1) * 4), d1_ = *(const LAS u32x2*)(vt + row * 72 + (cc >> 1) * 16 + 8 + (cc & 1) * 4);
            u32x4 dat; dat.x = d0_.x; dat.y = d0_.y; dat.z = d1_.x; dat.w = d1_.y;
            *(u32x4*)(VtA + (size_t)st * 256 + (size_t)hv * 64 * S + (size_t)d * S + (tok0 - st) + cc * 8) = dat; }
        pb_chunk(pp, ps, layer, PB, tok0, tid);
        __syncthreads();
    }
}
__device__ __forceinline__ void fixup_b(LAS unsigned char* lds, const bf16_t* Q, bf16_t* Qo, const bf16_t* KV, const float* KR, bf16_t* K, bf16_t* VtB, const float* qg, const float* kg, const f32x2* rope,
                                        int hf, int vcu, int G) {
    int tid_l = threadIdx.x; asm volatile("" : "+v"(tid_l));
    const int tid = tid_l, lane = tid & 63, wid = tid >> 6, sub = lane & 7, hl = lane >> 3;
    LAS bf16_t* vt = (LAS bf16_t*)lds;
    const float qscale = 0.10206207261596575f * LOG2E;
    for (int chunk = vcu; chunk < TH / 32; chunk += G) {
        const int lt0 = chunk * 32; int st, S; seq_of(hf * TH + lt0, st, S); const int lst = st - hf * TH;
        for (int ib = 0; ib < 2; ++ib) {
            f32x2 csb[2][4]; f32x4 krb[2]; u32x4 qn[2][2], kn[2][2], vn[2][2]; u32x2 qr2[2][2];
#pragma unroll
            for (int t = 0; t < 2; ++t) { const int lt = lt0 + wid * 4 + ib * 2 + t, pos = lt - lst; const int fi = 4 * (sub & 3);
#pragma unroll
                for (int e = 0; e < 4; ++e) csb[t][e] = rope[pos * 16 + fi + e];
                krb[t] = *(const f32x4*)(KR + (size_t)lt * 32 + sub * 4);
#pragma unroll
                for (int rr = 0; rr < 2; ++rr) { const int h = rr * 8 + hl; const bf16_t* qp = Q + (size_t)lt * 1536 + h * 96; const bf16_t* kvp = KV + (size_t)lt * 2048 + h * 128;
                    kn[t][rr] = *(const u32x4*)(kvp + sub * 8); vn[t][rr] = *(const u32x4*)(kvp + 64 + sub * 8); } }
#pragma unroll
            for (int t = 0; t < 2; ++t) { const int i = ib * 2 + t; const int lt = lt0 + wid * 4 + i; const f32x4 krv = krb[t];
#pragma unroll
                for (int rr = 0; rr < 2; ++rr) { const int h = rr * 8 + hl;
                    {
                        const u32x4 rn = kn[t][rr]; const u32x4 rv = vn[t][rr];
                        float a[8]; unpack8(rn, a); float b[4] = {krv[0], krv[1], krv[2], krv[3]};
                        float ss = 0.f;
#pragma unroll
                        for (int e = 0; e < 8; ++e) ss += a[e] * a[e];
#pragma unroll
                        for (int e = 0; e < 4; ++e) ss += b[e] * b[e];
                        ss += __shfl_xor(ss, 1); ss += __shfl_xor(ss, 2); ss += __shfl_xor(ss, 4);
                        const float rs = __builtin_amdgcn_rsqf(ss * (1.f / 96.f) + EPS);
#pragma unroll
                        for (int e = 0; e < 8; ++e) a[e] = a[e] * rs * kg[sub * 8 + e];
#pragma unroll
                        for (int e = 0; e < 4; ++e) { b[e] = b[e] * rs * kg[64 + sub * 4 + e]; const float pb = __shfl_xor(b[e], 4);
                            b[e] = sub < 4 ? b[e] * csb[t][e].x - pb * csb[t][e].y : pb * csb[t][e].y + b[e] * csb[t][e].x; }
                        bf16_t* kp = K + (size_t)lt * 1536 + h * 96;
                        *(u32x4*)(kp + sub * 8) = pack8(a); u32x2 w; w.x = cvt_pk_bf16(b[0], b[1]); w.y = cvt_pk_bf16(b[2], b[3]); *(u32x2*)(kp + 64 + sub * 4) = w;
                        const unsigned wv[4] = {rv.x, rv.y, rv.z, rv.w};
#pragma unroll
                        for (int e = 0; e < 8; ++e) vt[(h * 64 + sub * 8 + e) * 40 + wid * 4 + i] = (bf16_t)((e & 1) ? (wv[e >> 1] >> 16) : (wv[e >> 1] & 0xffffu));
                    } } } }
        __syncthreads();
#pragma unroll
        for (int k = 0; k < 8; ++k) { const int c = tid + 512 * k, row = c >> 2, cc = c & 3, h = row >> 6, d = row & 63;
            const u32x2 d0_ = *(const LAS u32x2*)(vt + row * 40 + (cc >> 1) * 16 + (cc & 1) * 4), d1_ = *(const LAS u32x2*)(vt + row * 40 + (cc >> 1) * 16 + 8 + (cc & 1) * 4);
            u32x4 dat; dat.x = d0_.x; dat.y = d0_.y; dat.z = d1_.x; dat.w = d1_.y;
            *(u32x4*)(VtB + (size_t)lst * 1024 + (size_t)h * 64 * S + (size_t)d * S + (lt0 - lst) + cc * 8) = dat; }
        __syncthreads();
    }
}


__global__ void __launch_bounds__(512, 2) mega(Args a) {
    extern __shared__ __attribute__((aligned(16))) unsigned char lds_raw[];
    LAS unsigned char* lds = (LAS unsigned char*)lds_raw;
    cg::grid_group grid = cg::this_grid();
    const int tid = threadIdx.x, lane = tid & 63, wid = __builtin_amdgcn_readfirstlane(tid >> 6);
    const int G = gridDim.x, bx = blockIdx.x, vcu = (G % 8 == 0) ? (bx % 8) * (G / 8) + bx / 8 : bx;
    const int gw = vcu * 8 + wid, NGW = G * 8;
#define ROPE ((f32x2*)(ws + WS_ROPE))
#define WL ((bf16_t*)(ws + WS_WL))
#define XB ((bf16_t*)(ws + WS_XB))
#define XB2 ((bf16_t*)(ws + WS_XB2))
#define SSV0 ((float*)(ws + WS_SS0))
#define SSV1 ((float*)(ws + WS_SS1))
#define SSL ((float*)(ws + WS_SSL))
#define PB ((bf16_t*)(ws + WS_PB))
#define Hb ((bf16_t*)(ws + WS_H))
#define PROJ ((bf16_t*)(ws + WS_PROJ))
#define QKV ((bf16_t*)(ws + WS_QKV))
#define VTA ((bf16_t*)(ws + WS_VTA))
#define LQ ((bf16_t*)(ws + WS_LQ))
#define LKV ((bf16_t*)(ws + WS_LKV))
#define KR ((float*)(ws + WS_KR))
#define Qh ((bf16_t*)(ws + WS_Q))
#define KVh ((bf16_t*)(ws + WS_KV))
#define Kh ((bf16_t*)(ws + WS_K))
#define VTB ((bf16_t*)(ws + WS_VTB))
#define SSa (s ? SSV1 : SSV0)
#define SSb (s ? SSV0 : SSV1)
    float* X = a.out;
    LAS float* scr = (LAS float*)(lds + wid * 16384);
    if (tid < 2) ((LAS unsigned*)(lds + 131072))[tid] = 0u;
    __syncthreads();
    const XcdBarrier xbar = xcd_barrier_post((unsigned*)(a.ws + WS_BAR), (volatile LAS unsigned*)(lds + 131072));
    int ph = 0; const int lo = a.ph_lo, hi = a.ph_hi;
#define PH_BEGIN if (ph >= lo && ph < hi) { unsigned char* ws = a.ws; asm volatile("" : "+s"(ws));
#define PH_END   if (ph + 1 < hi) { if (ph == 0) grid.sync(); else xcd_barrier(xbar); } } ++ph;
#define CVT_LAYER(L, part) cvt_layer(a, (L), WL, scr, gw, NGW, (part))
#ifndef EN
#define EN 0xffff
#endif
#ifndef DUP
#define DUP 0
#endif
#define REP(bit) for (int rep_ = ((DUP & (bit)) ? 0 : 1); rep_ < 2; ++rep_)
#define AMUL ((float)rep_)
#ifndef STAG_US
#define STAG_US 0
#endif
#define STAGGER(us) do { if (((bx >> 3) & 1) && (us) > 0) { const unsigned long long t0_ = __builtin_amdgcn_s_memrealtime(); while (__builtin_amdgcn_s_memrealtime() - t0_ < (unsigned long long)(us) * 100ull) __builtin_amdgcn_s_sleep(32); } } while (0)
#define GEMM(EpiT, g, E) do { pg8::StaticOrder S_; S_.init((g).M, (g).N, G, bx); pg8::gemm_phase<EpiT, pg8::StaticOrder, true, true>(lds, (g), S_, (E)); } while (0)

    PH_BEGIN

#if EN & 4096
        for (int idx = (vcu * 512 + tid); idx < 8192 * 16; idx += G * 512) { const int pos = idx >> 4, i = idx & 15; const float ang = (float)pos * INV_FREQ[i];
            double rev = (double)ang * 0.15915494309189535; rev -= __builtin_rint(rev); const float rf = (float)rev;
            f32x2 cs; cs.x = __builtin_amdgcn_cosf(rf); cs.y = __builtin_amdgcn_sinf(rf); ROPE[idx] = cs; }
        REP(4096) for (int row0 = gw * 4; row0 < TT; row0 += NGW * 4) {
            f32x4 v[4][4];
#pragma unroll
            for (int t = 0; t < 4; ++t) { const int e = ext_row(row0 + t); const float* src = e < 65536 ? a.in[0] + (size_t)e * DM : a.in[1] + (size_t)(e - 65536) * DM;
#pragma unroll
                for (int j = 0; j < 4; ++j) v[t][j] = *(const f32x4*)(src + (64 * j + lane) * 4); }
#pragma unroll
            for (int t = 0; t < 4; ++t) { const int row = row0 + t, e = ext_row(row); float s = 0.f;
#pragma unroll
                for (int j = 0; j < 4; ++j) s += (v[t][j][0] * v[t][j][0] + v[t][j][1] * v[t][j][1]) + (v[t][j][2] * v[t][j][2] + v[t][j][3] * v[t][j][3]);
                s = wave_sum(s);
#pragma unroll
                for (int j = 0; j < 4; ++j) { *(f32x4*)(X + (size_t)e * DM + (64 * j + lane) * 4) = v[t][j]; u32x2 w; w.x = cvt_pk_bf16(v[t][j][0], v[t][j][1]); w.y = cvt_pk_bf16(v[t][j][2], v[t][j][3]);
                    *(u32x2*)(XB2 + (size_t)row * DM + (64 * j + lane) * 4) = w; }
                if (lane < 16) SSV0[(size_t)row * 16 + lane] = lane == 0 ? s : 0.f; } }
        CVT_LAYER(0, 7);
#endif

    PH_END

#pragma nounroll
    for (int layer = 0; layer < 4; ++layer) {
        const int j = layer >> 1, s = layer & 1;
        if ((layer & 1) == 0) {
            PH_BEGIN
#if EN & 1
REP(1) { pg8::Gemm g{XB2, WL + WO_MIX, TT, 1536, 1024, 1024, 1024}; pg8::EpiScale E{QKV, 1536, pg8::RowScale{SSa, 0, 4, 1.f / 1024.f}}; GEMM(pg8::EpiScale, g, E); }
#endif
 if (layer > 0) CVT_LAYER(layer, 4); PH_END
            PH_BEGIN
#if EN & 2
fixup_a(lds, QKV, VTA, a.in[6] + j * 64, a.in[7] + j * 64, ROPE, vcu, G, a.in[2], a.in[3], layer, PB);
#endif
 PH_END
            PH_BEGIN

#if EN & 4
                for (int u = vcu; u < 3072; u += G) { const int blk = u % 768, kvh = u / 768; const int tok0 = blk * 128; int st, S; seq_of(tok0, st, S);
                    win_unit(lds, QKV, VTA, st, S, (tok0 - st) >> 7, kvh, a.in[8] + j * 16); }
#endif

            PH_END
            PH_BEGIN
#if EN & 8
STAGGER(STAG_US); REP(8) { pg8::Gemm g{QKV, WL + WO_MIX_O_A, TT, 1024, 1024, 1536, 1024}; pg8::EpiResid<false> E{X, 0, XB, SSb, nullptr, pg8::RowScale{nullptr, 0, 0, 0.f}, AMUL}; GEMM(pg8::EpiResid<false>, g, E); }
#endif
 PH_END
        } else {
            PH_BEGIN
#if EN & 16
REP(16) { pg8::Gemm g{XB2, WL + WO_MIX, TT, 768, 1024, 1024, 1024}; pg8::EpiLat E{LQ, LKV, KR, SSL, pg8::RowScale{SSa, 0, 4, 1.f / 1024.f}}; GEMM(pg8::EpiLat, g, E); }
#endif
 CVT_LAYER(layer, 4); PH_END
#pragma nounroll
            for (int hf = 0; hf < 2; ++hf) {
                PH_BEGIN

#if EN & 32
                    REP(32) { pg8::Gemm g{LQ + (size_t)hf * TH * 384, WL + WO_B_UQ, TH, 1536, 384, 384, 384}; pg8::EpiScale E{Qh, 1536, pg8::RowScale{SSL + (size_t)hf * TH * 16, 0, 2, 1.f / 384.f}}; GEMM(pg8::EpiScale, g, E); }
                    REP(32) { pg8::Gemm g{LKV + (size_t)hf * TH * 128, WL + WO_B_UKV, TH, 2048, 128, 128, 128}; pg8::EpiScale E{KVh, 2048, pg8::RowScale{SSL + (size_t)hf * TH * 16, 8, 1, 1.f / 128.f}}; GEMM(pg8::EpiScale, g, E); }
#endif

                PH_END
                PH_BEGIN

#if EN & 64
                    REP(64) fixup_b(lds, Qh, rep_ ? Qh : Kh, KVh, KR + (size_t)hf * TH * 32, Kh, VTB, a.in[15] + j * 96, a.in[16] + j * 96, ROPE, hf, vcu, G);
                    if (hf == 0) { int tp_ = threadIdx.x; asm volatile("" : "+v"(tp_)); for (int chunk = vcu; chunk < TT / 64; chunk += G) pb_chunk(a.in[2], a.in[3], layer, PB, chunk * 64, tp_); }
#endif

                PH_END
                PH_BEGIN

#if EN & 128
                    int tl_ = threadIdx.x; asm volatile("" : "+v"(tl_)); const int lane = tl_ & 63, wid = __builtin_amdgcn_readfirstlane(tl_ >> 6);
                    REP(128)
                    for (int u = vcu; u < 3072; u += G) { int sq0, S, h, qb;
                        if (u < 2048) { const int pair = u >> 5; qb = u & 31; S = 8192; sq0 = (pair >> 4) * 8192; h = pair & 15; }
                        else { const int v = u - 2048, pair = v >> 3; qb = v & 7; S = 2048; sq0 = 32768 + (pair >> 4) * 2048; h = pair & 15; }
                        const size_t qr = (size_t)(sq0 + qb * 256 + wid * 32 + (lane & 31));
                        attn_unit<96, false>(lds, Qh + qr * 1536 + h * 96, KVh + qr * 1024 + h * 64, Kh + (size_t)sq0 * 1536 + h * 96, 1536, VTB + (size_t)sq0 * 1024 + (size_t)h * 64 * S, S, 0, S >> 6, qb * 256 + wid * 32 + (lane & 31), 0.f, 0.f, a.in[15] + j * 96, ROPE); }
#endif

                PH_END
                PH_BEGIN
#if EN & 256
STAGGER(STAG_US); REP(256) { pg8::Gemm g{KVh, WL + WO_B_O, TH, 1024, 1024, 1024, 1024}; pg8::EpiResid<false> E{X, hf * TH, XB + (size_t)hf * TH * DM, SSb + (size_t)hf * TH * 16, nullptr, pg8::RowScale{nullptr, 0, 0, 0.f}, AMUL}; GEMM(pg8::EpiResid<false>, g, E); }
#endif
 PH_END
            }
        }
        PH_BEGIN
#if EN & 512
REP(512) { pg8::Gemm g{XB, WL + WO_GU, TT, 5632, 1024, 1024, 1024}; pg8::EpiSwiglu E{Hb, pg8::RowScale{SSb, 0, 4, 1.f / 1024.f}}; GEMM(pg8::EpiSwiglu, g, E); }
#endif
 if (layer < 3) CVT_LAYER(layer + 1, 1); PH_END
        PH_BEGIN

#if EN & 1024
            STAGGER((STAG_US * 2)); REP(1024) { pg8::Gemm g{Hb, WL + WO_D, TT, 1024, FFH, FFH, FFH}; pg8::EpiResid<false> E{X, 0, XB, SSa, nullptr, pg8::RowScale{nullptr, 0, 0, 0.f}, AMUL}; GEMM(pg8::EpiResid<false>, g, E); }
            REP(1024) { pg8::Gemm g{PB, WL + WO_PP, TT, 1024, PLE, PLE, PLE}; pg8::EpiScale E{PROJ, 1024, pg8::RowScale{nullptr, 0, 0, 0.f}}; GEMM(pg8::EpiScale, g, E); }
#endif

        PH_END
        PH_BEGIN
#if EN & 2048
STAGGER(STAG_US); REP(2048) { pg8::Gemm g{XB, WL + WO_PG, TT, 1024, 1024, 1024, 1024}; pg8::EpiResid<true> E{X, 0, XB2, SSb, PROJ, pg8::RowScale{SSa, 0, 4, 1.f / 1024.f}, AMUL}; GEMM(pg8::EpiResid<true>, g, E); }
#endif
 if (layer < 3) CVT_LAYER(layer + 1, 2); PH_END
    }
}

#ifndef N_LAUNCH_MODE
#define N_LAUNCH_MODE 1
#endif
constexpr int NPH = 39;
extern "C" void kernel_launch(void* const* d_in, const int* in_sizes, int n_in, void* d_out, int out_size, void* d_ws, size_t ws_size, hipStream_t stream) {
    static int grid = 0;
    if (grid == 0) {
        if (n_in != 24 || out_size != TT * DM || ws_size < WS_TOTAL) { fprintf(stderr, "kernel_launch: unexpected sizes n_in %d out %d ws %zu (need %zu)\n", n_in, out_size, ws_size, (size_t)WS_TOTAL); grid = -1; return; }
        int dev = 0, cus = 0, per_cu = 0;
        (void)hipGetDevice(&dev); (void)hipDeviceGetAttribute(&cus, hipDeviceAttributeMultiprocessorCount, dev);
        if (hipFuncSetAttribute((const void*)mega, hipFuncAttributeMaxDynamicSharedMemorySize, LDS_BYTES) != hipSuccess) { fprintf(stderr, "kernel_launch: hipFuncSetAttribute failed\n"); grid = -1; return; }
        if (hipOccupancyMaxActiveBlocksPerMultiprocessor(&per_cu, (const void*)mega, 512, LDS_BYTES) != hipSuccess || per_cu < 1) { fprintf(stderr, "kernel_launch: occupancy query %d\n", per_cu); per_cu = 1; }
        (void)hipGetLastError();
        grid = cus * 1;
        if (grid <= 0) grid = 256;
    }
    if (grid < 0) return;
    if (hipMemsetAsync((char*)d_ws + WS_BAR, 0, WS_BAR_BYTES, stream) != hipSuccess) { fprintf(stderr, "kernel_launch: memset failed\n"); return; }
    Args a{};
    for (int i = 0; i < 24; ++i) a.in[i] = (const float*)d_in[i];
    a.out = (float*)d_out; a.ws = (unsigned char*)d_ws;
#if N_LAUNCH_MODE == 1
    a.ph_lo = 0; a.ph_hi = 1 << 20;
    void* args[] = {&a};
    hipError_t e = hipLaunchCooperativeKernel((const void*)mega, dim3(grid), dim3(512), args, LDS_BYTES, stream);
    if (e != hipSuccess) fprintf(stderr, "cooperative launch failed: %s (grid %d)\n", hipGetErrorString(e), grid);
#else
    for (int p = 0; p < NPH; ++p) { a.ph_lo = p; a.ph_hi = p + 1; hipLaunchKernelGGL(mega, dim3(grid), dim3(512), LDS_BYTES, stream, a); }
#endif
}
```

```cpp
#include <hip/hip_runtime.h>
#include <hip/hip_cooperative_groups.h>
#include <cstdio>
#include <cstdint>
namespace cg = cooperative_groups;

constexpr int TT = 98304;
constexpr int TH = 49152;
constexpr int DM = 1024, FFH = 2816, PLE = 256;
constexpr float EPS = 1e-6f;
constexpr float LOG2E = 1.4426950408889634f;

__device__ __forceinline__ int ext_row(int r) { const int h = r >= TH ? 1 : 0; const int o = r - h * TH; return o < 32768 ? h * 32768 + o : 65536 + h * 16384 + (o - 32768); }
__device__ __forceinline__ void seq_of(int tok, int& st, int& S) { const int h = tok >= TH ? 1 : 0; const int o = tok - h * TH;
    if (o < 32768) { S = 8192; st = h * TH + (o & ~8191); } else { S = 2048; st = h * TH + 32768 + ((o - 32768) & ~2047); } }

namespace pg8 {
#define PG8_LAS __attribute__((address_space(3)))
typedef unsigned short bf16_t;
typedef short bf16x8 __attribute__((ext_vector_type(8)));
typedef float f32x4 __attribute__((ext_vector_type(4)));
typedef unsigned u32x4 __attribute__((ext_vector_type(4)));
constexpr int BM = 256, BK = 64, HALF = 128, HTB = HALF * BK * 2  , STAGE_BYTES = 8 * HTB, NXCD = 8, WGM = 8;

__host__ __device__ __forceinline__ int lds_byte(int r, int c) { const int st = (r >> 4) * 2 + (c >> 5), rr = r & 15, cc = c & 31, ob = rr * 64 + cc * 2; return st * 1024 + (ob ^ (((ob >> 9) & 1) << 5)); }
__host__ __device__ __forceinline__ void stage_rc(int b, int& R, int& C) { const int st = b / 1024, sb = b % 1024, swz = sb ^ (((sb >> 9) & 1) << 5); R = (st >> 1) * 16 + swz / 64; C = (st & 1) * 32 + (swz % 64) / 2; }
__host__ __device__ __forceinline__ int perm32(int rho) { const int n = rho >> 4, i = rho & 15; return 8 * (i >> 2) + 4 * n + (i & 3); }

struct Unit { int pm, pn; };
struct Gemm { const bf16_t* A; const bf16_t* Bt; int M, N, K, lda, ldb; };

struct StaticOrder {
    int nM, nN, nwg, G, c;
    __host__ __device__ void init(int M, int N, int G_, int c_) { nM = M / BM; nN = N / BM; nwg = nM * nN; G = G_; c = c_; }
    __host__ __device__ bool next(int i, Unit& u) const {
        const long L = (long)i * G + c; if (L >= nwg) return false;
        int wgid = (int)L; { const int q = nwg / NXCD, r = nwg % NXCD, xcd = wgid % NXCD, off = wgid / NXCD; wgid = (xcd < r ? xcd * (q + 1) : r * (q + 1) + (xcd - r) * q) + off; }
        const int nig = WGM * nN, gid = wgid / nig, fm = gid * WGM, gsz = (nM - fm) < WGM ? (nM - fm) : WGM;
        u.pm = fm + ((wgid % nig) % gsz); u.pn = (wgid % nig) / gsz; return true;
    }
    __device__ __forceinline__ void a_ready(const Unit&) const {}
    __device__ __forceinline__ void done(const Unit&) const {}
};

__device__ __forceinline__ unsigned cvt_pk_bf16(float lo, float hi) { unsigned r; asm volatile("v_cvt_pk_bf16_f32 %0, %1, %2" : "=v"(r) : "v"(lo), "v"(hi)); return r; }
typedef unsigned u32x2 __attribute__((ext_vector_type(2)));
__device__ __forceinline__ float bf_lo(unsigned w) { return __uint_as_float(w << 16); }
__device__ __forceinline__ float bf_hi(unsigned w) { return __uint_as_float(w & 0xffff0000u); }

struct RowScale { const float* ss; int s0, ns4; float inv_dim;
    __device__ __forceinline__ float get(int row) const {
        if (!ss) return 1.f;
        const f32x4* p = (const f32x4*)(ss + (size_t)row * 16 + s0); float s = 0.f;
        for (int i = 0; i < ns4; ++i) { const f32x4 v = p[i]; s += (v[0] + v[1]) + (v[2] + v[3]); }
        return __builtin_amdgcn_rsqf(s * inv_dim + EPS);
    } };

template <bool NT> struct EpiScaleT {
    static constexpr bool PERM = true, AFTER_DRAIN = false;
    bf16_t* O; int ldc; RowScale rs;
    __device__ __forceinline__ void operator()(const f32x4 (&acc)[2][2][4][2], const Unit& u, int wr, int wc, int fr, int fq) const {
        const int row0 = u.pm * BM + wr * 64 + fr, col0 = u.pn * BM + wc * 32 + 8 * fq;
#pragma unroll
        for (int ai = 0; ai < 2; ++ai)
#pragma unroll
            for (int m = 0; m < 4; ++m) { const int row = row0 + ai * HALF + m * 16; const float s = rs.get(row); bf16_t* rp = O + (size_t)row * ldc + col0;
#pragma unroll
                for (int bj = 0; bj < 2; ++bj) { const f32x4 v0 = acc[ai][bj][m][0] * s, v1 = acc[ai][bj][m][1] * s; u32x4 w; w.x = cvt_pk_bf16(v0[0], v0[1]); w.y = cvt_pk_bf16(v0[2], v0[3]); w.z = cvt_pk_bf16(v1[0], v1[1]); w.w = cvt_pk_bf16(v1[2], v1[3]);
                    if (NT) __builtin_nontemporal_store(w, (u32x4*)(rp + bj * HALF)); else *(u32x4*)(rp + bj * HALF) = w; } }
    }
};
typedef EpiScaleT<false> EpiScale;

struct EpiLat {
    static constexpr bool PERM = false, AFTER_DRAIN = false;
    bf16_t* LQ; bf16_t* LKV; float* KR; float* SSL; RowScale rs;
    __device__ __forceinline__ void operator()(const f32x4 (&acc)[2][2][4][2], const Unit& u, int wr, int wc, int fr, int fq) const {
        const int row0 = u.pm * BM + wr * 64 + fr, col0 = u.pn * BM + wc * 32 + 4 * fq;
#pragma unroll
        for (int ai = 0; ai < 2; ++ai)
#pragma unroll
            for (int m = 0; m < 4; ++m) { const int row = row0 + ai * HALF + m * 16; const float s = rs.get(row); float q[2] = {0.f, 0.f};
#pragma unroll
                for (int bj = 0; bj < 2; ++bj)
#pragma unroll
                    for (int n = 0; n < 2; ++n) { const f32x4 v = acc[ai][bj][m][n] * s; q[bj] += (v[0] * v[0] + v[1] * v[1]) + (v[2] * v[2] + v[3] * v[3]);
                        const int col = col0 + bj * HALF + n * 16; u32x2 w; w.x = cvt_pk_bf16(v[0], v[1]); w.y = cvt_pk_bf16(v[2], v[3]);
                        if (col < 384) *(u32x2*)(LQ + (size_t)row * 384 + col) = w;
                        else if (col < 512) *(u32x2*)(LKV + (size_t)row * 128 + (col - 384)) = w;
                        else if (col < 544) *(f32x4*)(KR + (size_t)row * 32 + (col - 512)) = v; }
                float q0 = q[0], q1 = q[1];
                q0 += __shfl_xor(q0, 16); q0 += __shfl_xor(q0, 32); q1 += __shfl_xor(q1, 16); q1 += __shfl_xor(q1, 32);
                if (fq == 0) { if (u.pn == 0) SSL[(size_t)row * 16 + wc] = q0 + q1; else if (u.pn == 1) { SSL[(size_t)row * 16 + 4 + wc] = q0; SSL[(size_t)row * 16 + 8 + wc] = q1; } } }
    }
};

struct EpiSwiglu {
    static constexpr bool PERM = true, AFTER_DRAIN = false;
    bf16_t* H; RowScale rs;
    __device__ __forceinline__ void operator()(const f32x4 (&acc)[2][2][4][2], const Unit& u, int wr, int wc, int fr, int fq) const {
        const int row0 = u.pm * BM + wr * 64 + fr, col0 = u.pn * HALF + wc * 32 + 8 * fq;
#pragma unroll
        for (int ai = 0; ai < 2; ++ai)
#pragma unroll
            for (int m = 0; m < 4; ++m) { const int row = row0 + ai * HALF + m * 16; const float s = rs.get(row); bf16_t* rp = H + (size_t)row * FFH + col0; float h[8];
#pragma unroll
                for (int n = 0; n < 2; ++n) { const f32x4 g = acc[ai][0][m][n] * s, up = acc[ai][1][m][n] * s;
#pragma unroll
                    for (int j = 0; j < 4; ++j) h[4 * n + j] = g[j] * __builtin_amdgcn_rcpf(1.f + __builtin_amdgcn_exp2f(-g[j] * LOG2E)) * up[j]; }
                u32x4 w; w.x = cvt_pk_bf16(h[0], h[1]); w.y = cvt_pk_bf16(h[2], h[3]); w.z = cvt_pk_bf16(h[4], h[5]); w.w = cvt_pk_bf16(h[6], h[7]); __builtin_nontemporal_store(w, (u32x4*)rp); }
    }
};

template <bool PLEG> struct EpiResid {
    static constexpr bool PERM = true, AFTER_DRAIN = false;
    static constexpr int MB = PLEG ? 2 : 4;
    float* X; int row_int0; bf16_t* XBo; float* SSn; const bf16_t* PROJ; RowScale rs; float amul; bool wxb;
    __device__ __forceinline__ void operator()(const f32x4 (&acc)[2][2][4][2], const Unit& u, int wr, int wc, int fr, int fq) const {
        const int ext0 = ext_row(row_int0 + u.pm * BM); const int col0 = u.pn * BM + wc * 32 + 8 * fq;
#pragma unroll
        for (int ai = 0; ai < 2; ++ai)
#pragma unroll
            for (int mb = 0; mb < 4; mb += MB) {
                f32x4 xo[MB][2][2]; u32x4 pw[MB][2]; float sv[MB];
#pragma unroll
                for (int mm = 0; mm < MB; ++mm) { const int m = mb + mm; const int lrow = wr * 64 + fr + ai * HALF + m * 16, row = u.pm * BM + lrow; const float* xp = X + (size_t)(ext0 + lrow) * DM + col0;
                    sv[mm] = PLEG ? rs.get(row) : 0.f;
#pragma unroll
                    for (int bj = 0; bj < 2; ++bj) { xo[mm][bj][0] = *(const f32x4*)(xp + bj * HALF); xo[mm][bj][1] = *(const f32x4*)(xp + bj * HALF + 4);
                        if (PLEG) pw[mm][bj] = *(const u32x4*)(PROJ + (size_t)row * DM + col0 + bj * HALF); } }
                asm volatile("" ::: "memory");
#pragma unroll
                for (int mm = 0; mm < MB; ++mm) { const int m = mb + mm; const int lrow = wr * 64 + fr + ai * HALF + m * 16, row = u.pm * BM + lrow; float* xp = X + (size_t)(ext0 + lrow) * DM + col0;
                    const float s = sv[mm]; float q = 0.f;
#pragma unroll
                    for (int bj = 0; bj < 2; ++bj) { f32x4 xn[2];
#pragma unroll
                        for (int n = 0; n < 2; ++n) { const f32x4 a = acc[ai][bj][m][n];
                            if (PLEG) { const unsigned w0 = n == 0 ? pw[mm][bj].x : pw[mm][bj].z, w1 = n == 0 ? pw[mm][bj].y : pw[mm][bj].w; const float p[4] = {bf_lo(w0), bf_hi(w0), bf_lo(w1), bf_hi(w1)};
#pragma unroll
                                for (int j = 0; j < 4; ++j) xn[n][j] = xo[mm][bj][n][j] + __builtin_amdgcn_rcpf(1.f + __builtin_amdgcn_exp2f(-a[j] * s * LOG2E)) * p[j] * amul; }
                            else xn[n] = xo[mm][bj][n] + a * amul;
                            *(f32x4*)(xp + bj * HALF + 4 * n) = xn[n];
                            q += (xn[n][0] * xn[n][0] + xn[n][1] * xn[n][1]) + (xn[n][2] * xn[n][2] + xn[n][3] * xn[n][3]); }
                        u32x4 w; w.x = cvt_pk_bf16(xn[0][0], xn[0][1]); w.y = cvt_pk_bf16(xn[0][2], xn[0][3]); w.z = cvt_pk_bf16(xn[1][0], xn[1][1]); w.w = cvt_pk_bf16(xn[1][2], xn[1][3]);
                        if (wxb) *(u32x4*)(XBo + (size_t)row * DM + col0 + bj * HALF) = w; }
                    q += __shfl_xor(q, 16); q += __shfl_xor(q, 32);
                    if (fq == 0 && wxb) SSn[(size_t)row * 16 + u.pn * 4 + wc] = q; }
                asm volatile("" ::: "memory");
            }
    }
};

template <class Epi, class Sched, bool ALIGN_EPI = false, bool SP2 = false>
__device__ __forceinline__ void gemm_phase(PG8_LAS unsigned char* lds, const Gemm g, const Sched& S, const Epi& E) {
    int tid_l = threadIdx.x; asm volatile("" : "+v"(tid_l));
    const int tid = tid_l, wid = __builtin_amdgcn_readfirstlane(tid >> 6), lane = tid & 63, wr = wid >> 2, wc = wid & 3, fr = lane & 15, fq = lane >> 4;
    const int K = g.K, nt = K / BK;
    unsigned voffA[2], voffB[2];
#pragma unroll
    for (int i = 0; i < 2; ++i) { int R, C; stage_rc(tid * 16 + i * 8192, R, C); const int Rb = Epi::PERM ? ((R & ~31) + perm32(R & 31)) : R;
        voffA[i] = (unsigned)(R * g.lda + C) * 2u; voffB[i] = (unsigned)(Rb * g.ldb + C) * 2u; }
    const size_t kstep = (size_t)(BK * 2);
    const size_t hstepA = (size_t)HALF * g.lda * 2, hstepB = (size_t)HALF * g.ldb * 2;
    const size_t tstepA = 2 * hstepA, tstepB = 2 * hstepB;
    const unsigned ldsw = (unsigned)wid * 1024u;
    const int aoff = lds_byte(wr * 64 + fr, fq * 8), boff = lds_byte(wc * 32 + fr, fq * 8);
#define PG8_SA(b, h) (((b) * 2 + (h)) * HTB)
#define PG8_SB(b, h) ((4 + (b) * 2 + (h)) * HTB)
#define PG8_STAGE(bufoff, gbase, voff) do { _Pragma("unroll") for (int _i = 0; _i < 2; ++_i) \
        __builtin_amdgcn_global_load_lds((const unsigned*)((const char*)(gbase) + (voff)[_i]), (PG8_LAS unsigned*)(lds + (bufoff) + ldsw + _i * 8192), 16, 0, 0); } while (0)
#define PG8_LDA(dst, b, h) do { _Pragma("unroll") for (int m = 0; m < 4; ++m) _Pragma("unroll") for (int k = 0; k < 2; ++k) dst[m][k] = *(const PG8_LAS bf16x8*)(lds + PG8_SA(b, h) + aoff + m * 2048 + k * 1024); } while (0)
#define PG8_LDB(dst, b, h) do { _Pragma("unroll") for (int n = 0; n < 2; ++n) _Pragma("unroll") for (int k = 0; k < 2; ++k) dst[n][k] = *(const PG8_LAS bf16x8*)(lds + PG8_SB(b, h) + boff + n * 2048 + k * 1024); } while (0)
#define PG8_MMA(ai, bj, At, Bt) do { __builtin_amdgcn_s_setprio(1); _Pragma("unroll") for (int m = 0; m < 4; ++m) _Pragma("unroll") for (int n = 0; n < 2; ++n) _Pragma("unroll") for (int k = 0; k < 2; ++k) \
        acc[ai][bj][m][n] = __builtin_amdgcn_mfma_f32_16x16x32_bf16(Bt[n][k], At[m][k], acc[ai][bj][m][n], 0, 0, 0); __builtin_amdgcn_s_setprio(0); } while (0)
#define PG8_WAIT_V(n) asm volatile("s_waitcnt vmcnt(" #n ")" ::: "memory")
#define PG8_WAIT_L(n) asm volatile("s_waitcnt lgkmcnt(" #n ")" ::: "memory")
#define PG8_BAR __builtin_amdgcn_s_barrier()
#define PG8_SCHED __builtin_amdgcn_sched_barrier(0)
    Unit cur, nxt; int ui = 0;
    if (!S.next(0, cur)) return;
    f32x4 acc[2][2][4][2];
#pragma unroll
    for (int a = 0; a < 2; ++a)
#pragma unroll
        for (int b = 0; b < 2; ++b)
#pragma unroll
            for (int m = 0; m < 4; ++m)
#pragma unroll
                for (int n = 0; n < 2; ++n) acc[a][b][m][n] = (f32x4){0.f, 0.f, 0.f, 0.f};
    bf16x8 At[4][2], B0[2][2], B1[2][2];
    const char* cA = (const char*)g.A + (size_t)cur.pm * tstepA; const char* cB = (const char*)g.Bt + (size_t)cur.pn * tstepB;
    S.a_ready(cur);
    if constexpr (SP2) {
        PG8_STAGE(PG8_SB(0, 0), cB, voffB); PG8_STAGE(PG8_SB(0, 1), cB + hstepB, voffB); PG8_STAGE(PG8_SA(0, 0), cA, voffA); PG8_STAGE(PG8_SA(0, 1), cA + hstepA, voffA);
        if (wr == 1) PG8_BAR;
        PG8_WAIT_V(2); PG8_BAR;
        PG8_STAGE(PG8_SB(1, 0), cB + kstep, voffB); PG8_STAGE(PG8_SA(1, 0), cA + kstep, voffA); PG8_STAGE(PG8_SB(1, 1), cB + hstepB + kstep, voffB);
        PG8_WAIT_V(6); PG8_BAR;
    } else {
        PG8_STAGE(PG8_SB(0, 0), cB, voffB); PG8_STAGE(PG8_SA(0, 0), cA, voffA); PG8_STAGE(PG8_SB(0, 1), cB + hstepB, voffB); PG8_STAGE(PG8_SA(0, 1), cA + hstepA, voffA);
        if (wr == 1) PG8_BAR;
        PG8_WAIT_V(4); PG8_BAR;
        PG8_STAGE(PG8_SB(1, 0), cB + kstep, voffB); PG8_STAGE(PG8_SA(1, 0), cA + kstep, voffA); PG8_STAGE(PG8_SB(1, 1), cB + hstepB + kstep, voffB);
        PG8_WAIT_V(6); PG8_BAR;
    }
    for (;;) {
        const bool has_next = S.next(ui + 1, nxt);
        const char* nA = has_next ? (const char*)g.A + (size_t)nxt.pm * tstepA : cA; const char* nB = has_next ? (const char*)g.Bt + (size_t)nxt.pn * tstepB : cB;
        for (int t = 0; t < nt; t += 2) {
            const bool last = (t == nt - 2);
            const char* a1 = cA + (size_t)(t + 1) * kstep;
            const char* a2 = last ? nA : cA + (size_t)(t + 2) * kstep; const char* b2 = last ? nB : cB + (size_t)(t + 2) * kstep;
            const char* a3 = a2 + kstep; const char* b3 = b2 + kstep;
            if (last && has_next) S.a_ready(nxt);
            if constexpr (SP2) {
            PG8_LDB(B0, 0, 0); PG8_LDB(B1, 0, 1); PG8_SCHED; PG8_LDA(At, 0, 0); PG8_STAGE(PG8_SA(1, 1), a1 + hstepA, voffA);
            PG8_WAIT_V(8); PG8_WAIT_L(0); PG8_BAR; PG8_MMA(0, 0, At, B0); PG8_MMA(0, 1, At, B1); PG8_BAR; PG8_SCHED;
            PG8_LDA(At, 0, 1); PG8_STAGE(PG8_SB(0, 0), b2, voffB); PG8_STAGE(PG8_SB(0, 1), b2 + hstepB, voffB); PG8_STAGE(PG8_SA(0, 0), a2, voffA);
            PG8_WAIT_V(8); PG8_WAIT_L(0); PG8_BAR; PG8_MMA(1, 0, At, B0); PG8_MMA(1, 1, At, B1); PG8_BAR; PG8_SCHED;
            PG8_LDB(B0, 1, 0); PG8_LDB(B1, 1, 1); PG8_SCHED; PG8_LDA(At, 1, 0); PG8_STAGE(PG8_SA(0, 1), a2 + hstepA, voffA);
            PG8_WAIT_V(8); PG8_WAIT_L(0); PG8_BAR; PG8_MMA(0, 0, At, B0); PG8_MMA(0, 1, At, B1); PG8_BAR; PG8_SCHED;
            PG8_LDA(At, 1, 1); PG8_STAGE(PG8_SB(1, 0), b3, voffB); PG8_STAGE(PG8_SB(1, 1), b3 + hstepB, voffB); PG8_STAGE(PG8_SA(1, 0), a3, voffA);
            PG8_WAIT_V(8); PG8_WAIT_L(0); PG8_BAR; PG8_MMA(1, 0, At, B0); PG8_MMA(1, 1, At, B1); PG8_BAR; PG8_SCHED;
            } else {
            PG8_LDB(B0, 0, 0); PG8_SCHED; PG8_LDA(At, 0, 0); PG8_STAGE(PG8_SA(1, 1), a1 + hstepA, voffA);
            PG8_WAIT_L(8); PG8_BAR; PG8_WAIT_L(0); PG8_MMA(0, 0, At, B0); PG8_BAR; PG8_SCHED;
            PG8_LDB(B1, 0, 1); PG8_STAGE(PG8_SB(0, 0), b2, voffB);
            PG8_BAR; PG8_WAIT_L(0); PG8_MMA(0, 1, At, B1); PG8_BAR;
            PG8_LDA(At, 0, 1); PG8_STAGE(PG8_SA(0, 0), a2, voffA);
            PG8_BAR; PG8_WAIT_L(0); PG8_MMA(1, 0, At, B0); PG8_BAR; PG8_SCHED;
            PG8_STAGE(PG8_SB(0, 1), b2 + hstepB, voffB);
            PG8_WAIT_V(6); PG8_BAR; PG8_MMA(1, 1, At, B1); PG8_BAR;
            PG8_LDB(B0, 1, 0); PG8_SCHED; PG8_LDA(At, 1, 0); PG8_STAGE(PG8_SA(0, 1), a2 + hstepA, voffA);
            PG8_WAIT_L(8); PG8_BAR; PG8_WAIT_L(0); PG8_MMA(0, 0, At, B0); PG8_BAR; PG8_SCHED;
            PG8_LDB(B1, 1, 1); PG8_STAGE(PG8_SB(1, 0), b3, voffB);
            PG8_BAR; PG8_WAIT_L(0); PG8_MMA(0, 1, At, B1); PG8_BAR;
            PG8_LDA(At, 1, 1); PG8_STAGE(PG8_SA(1, 0), a3, voffA);
            PG8_BAR; PG8_WAIT_L(0); PG8_MMA(1, 0, At, B0); PG8_BAR; PG8_SCHED;
            PG8_STAGE(PG8_SB(1, 1), b3 + hstepB, voffB);
            PG8_WAIT_V(6); PG8_BAR; PG8_MMA(1, 1, At, B1); PG8_BAR;
            }
        }
        if constexpr (ALIGN_EPI) { if (wr == 0) PG8_BAR; }
        if constexpr (!Epi::AFTER_DRAIN) { E(acc, cur, wr, wc, fr, fq); S.done(cur); }
        if (!has_next) break;
#pragma unroll
        for (int a = 0; a < 2; ++a)
#pragma unroll
            for (int b = 0; b < 2; ++b)
#pragma unroll
                for (int m = 0; m < 4; ++m)
#pragma unroll
                    for (int n = 0; n < 2; ++n) acc[a][b][m][n] = (f32x4){0.f, 0.f, 0.f, 0.f};
        cur = nxt; cA = nA; cB = nB; ++ui;
        if constexpr (ALIGN_EPI) { if (wr == 1) PG8_BAR; }
    }
    PG8_WAIT_V(0);
    if constexpr (!ALIGN_EPI) { if (wr == 0) PG8_BAR; }
    PG8_BAR;
    if constexpr (Epi::AFTER_DRAIN) { E.fused(acc, cur, wr, wc, fr, fq, lds, wid, lane); S.done(cur); }
#undef PG8_SA
#undef PG8_SB
#undef PG8_STAGE
#undef PG8_LDA
#undef PG8_LDB
#undef PG8_MMA
#undef PG8_WAIT_V
#undef PG8_WAIT_L
#undef PG8_BAR
#undef PG8_SCHED
}
}

#define LAS __attribute__((address_space(3)))
typedef unsigned short bf16_t;
using pg8::bf16x8; using pg8::f32x4; using pg8::u32x4; using pg8::u32x2; using pg8::cvt_pk_bf16; using pg8::bf_lo; using pg8::bf_hi;
typedef float f32x16 __attribute__((ext_vector_type(16)));
typedef float f32x2 __attribute__((ext_vector_type(2)));

#define XB_TMO      128
#define XB_XCNT(j)  (256  + 64 * (j))
#define XB_XSUB(j)  (1280 + 64 * (j))
#define XB_XGEN(j)  (2304 + 64 * (j))
#define XB_TOP      3328
#define XB_TOPGEN   3392
#define XCD_BAR_WORDS 3456
#define XB_SPIN_CAP (1u << 18)

__device__ __forceinline__ unsigned xb_ld(unsigned* p)              { return __hip_atomic_load(p, __ATOMIC_RELAXED, __HIP_MEMORY_SCOPE_AGENT); }
__device__ __forceinline__ unsigned xb_add(unsigned* p, unsigned v) { return __hip_atomic_fetch_add(p, v, __ATOMIC_RELAXED, __HIP_MEMORY_SCOPE_AGENT); }
__device__ __forceinline__ unsigned xb_xcc_id() { return (unsigned)__builtin_amdgcn_s_getreg((3 << 11) | 20) & 0xFu; }
#define XB_SPIN(cond, bar) do { unsigned _sp = 0; while (cond) { __builtin_amdgcn_s_sleep(1); \
    if ((++_sp & 255u) == 0u) { if (xb_ld(&(bar)[XB_TMO])) break; if (_sp > XB_SPIN_CAP) { atomicAdd(&(bar)[XB_TMO], 1u); break; } } } } while (0)

struct XcdBarrier {
    unsigned* bar; unsigned x;
    volatile LAS unsigned* st;
};

__device__ __forceinline__ XcdBarrier xcd_barrier_post(unsigned* bar, volatile LAS unsigned* st) {
    XcdBarrier b; b.bar = bar; b.x = xb_xcc_id(); b.st = st;
    if (threadIdx.x == 0) (void)xb_add(&bar[XB_XCNT(b.x)], 1u);
    return b;
}
__device__ __forceinline__ void xcd_barrier_complete(unsigned* bar, unsigned x, unsigned& nloc, unsigned& nx) {
    const unsigned G = gridDim.x * gridDim.y * gridDim.z;
    unsigned sum, cnt, mine, sp = 0u;
    for (;;) {
        sum = 0u; cnt = 0u; mine = 0u;
#pragma unroll
        for (unsigned j = 0; j < 16; ++j) { const unsigned c = xb_ld(&bar[XB_XCNT(j)]); sum += c; cnt += (c > 0u) ? 1u : 0u; mine = (j == x) ? c : mine; }
        if (sum == G) break;
        __builtin_amdgcn_s_sleep(1);
        if ((++sp & 255u) == 0u) { if (xb_ld(&bar[XB_TMO])) break; if (sp > XB_SPIN_CAP) { atomicAdd(&bar[XB_TMO], 1u); break; } }
    }
    nloc = mine > 0u ? mine : 1u; nx = cnt > 0u ? cnt : 1u;
}

__device__ __forceinline__ void xcd_barrier(const XcdBarrier& b) {
    asm volatile("s_waitcnt vmcnt(0)" ::: "memory");
    __syncthreads();
    if (threadIdx.x == 0) {
        unsigned* bar = b.bar;
        __builtin_amdgcn_s_waitcnt(0);
        unsigned nloc = b.st[0], nx = b.st[1];
        if (nloc == 0u) { xcd_barrier_complete(bar, b.x, nloc, nx); b.st[0] = nloc; b.st[1] = nx; }
        const unsigned old = xb_add(&bar[XB_XSUB(b.x)], 1u);
        const unsigned gen = old / nloc;
        if (old + 1u == (gen + 1u) * nloc) {
            __builtin_amdgcn_fence(__ATOMIC_RELEASE, "agent");
            asm volatile("s_waitcnt vmcnt(0)" ::: "memory");
            const unsigned og = xb_add(&bar[XB_TOP], 1u);
            const unsigned tg = og / nx;
            if (og + 1u == (tg + 1u) * nx) xb_add(&bar[XB_TOPGEN], 1u);
            else XB_SPIN(xb_ld(&bar[XB_TOPGEN]) == tg, bar);
            __builtin_amdgcn_fence(__ATOMIC_ACQUIRE, "agent");
            xb_add(&bar[XB_XGEN(b.x)], 1u);
            asm volatile("s_waitcnt vmcnt(0)" ::: "memory");
        } else {
            XB_SPIN(xb_ld(&bar[XB_XGEN(b.x)]) == gen, bar);
            __builtin_amdgcn_fence(__ATOMIC_ACQUIRE, "agent");
            asm volatile("s_waitcnt vmcnt(0)" ::: "memory");
        }
    }
    __syncthreads();
}

constexpr size_t MiB = 1u << 20;
constexpr size_t WS_ROPE = 0;
constexpr size_t WS_WL = 1 * MiB;
constexpr size_t WS_XB = 26 * MiB;
constexpr size_t WS_SS0 = 218 * MiB, WS_SS1 = 224 * MiB, WS_SSL = 230 * MiB;
constexpr size_t WS_PB = 236 * MiB;
constexpr size_t WS_TR = 284 * MiB;
constexpr size_t WS_XB2 = WS_TR;
constexpr size_t WS_H = WS_TR;
constexpr size_t WS_PROJ = 812 * MiB;
constexpr size_t WS_QKV = 476 * MiB;
constexpr size_t WS_VTA = 764 * MiB;
constexpr size_t WS_LQ = 476 * MiB, WS_LKV = 548 * MiB, WS_KR = 572 * MiB;
constexpr size_t WS_Q = WS_TR;
constexpr size_t WS_KV = 584 * MiB;
constexpr size_t WS_K = 776 * MiB;
constexpr size_t WS_VTB = 920 * MiB;
constexpr size_t WS_END = 1016 * MiB;
constexpr size_t WS_BAR = WS_END, WS_BAR_BYTES = 16384, WS_TOTAL = WS_BAR + WS_BAR_BYTES;
static_assert(XCD_BAR_WORDS * 4 <= WS_BAR_BYTES, "barrier words");
static_assert(WS_H + (size_t)TT * FFH * 2 <= WS_PROJ && WS_PROJ + (size_t)TT * DM * 2 <= WS_END, "ffn map");
static_assert(WS_XB2 + (size_t)TT * DM * 2 <= WS_QKV && WS_QKV + (size_t)TT * 1536 * 2 <= WS_VTA && WS_VTA + (size_t)TT * 256 * 2 <= WS_PROJ, "mixer A map");
static_assert(WS_LQ + (size_t)TT * 384 * 2 <= WS_LKV && WS_LKV + (size_t)TT * 128 * 2 <= WS_KR && WS_KR + (size_t)TT * 32 * 4 <= WS_KV, "mixer B map 1");
static_assert(WS_Q + (size_t)TH * 1536 * 2 <= WS_LQ && WS_KV + (size_t)TH * 2048 * 2 <= WS_K && WS_K + (size_t)TH * 1536 * 2 <= WS_VTB && WS_VTB + (size_t)TH * 1024 * 2 <= WS_END, "mixer B map 2");
static_assert(WS_XB + (size_t)TT * DM * 2 <= WS_SS0 && WS_PB + (size_t)TT * PLE * 2 <= WS_TR, "fixed map");
constexpr size_t WE = 1u << 20;
constexpr size_t WO_MIX = 0, WO_MIX_O_A = WE * 3 / 2;
constexpr size_t WO_B_UQ = WE * 3 / 4, WO_B_UKV = WE * 21 / 16, WO_B_O = WE * 25 / 16;
constexpr size_t WO_GU = 3 * WE, WO_D = WE * 17 / 2, WO_PG = WE * 45 / 4, WO_PP = WE * 49 / 4, WO_END = WE * 25 / 2;
static_assert(WO_B_UQ == 768u * 1024 && WO_B_UKV == WO_B_UQ + 1536u * 384 && WO_B_O == WO_B_UKV + 2048u * 128 && WO_B_O + WE <= WO_GU, "weight map B");
static_assert(WO_D == WO_GU + 5632u * 1024 && WO_PG == WO_D + 1024u * 2816 && WO_PP == WO_PG + WE && WO_END == WO_PP + 1024u * 256 && WO_END * 2 <= 25 * MiB, "weight map");

constexpr int LDS_BYTES = 131072 + 1024;
__constant__ float INV_FREQ[16] = {1.000000000e+00f, 4.403666258e-01f, 1.939227581e-01f, 8.539710194e-02f, 3.760603070e-02f, 1.656044088e-02f, 7.292665076e-03f, 3.211446106e-03f,
                                   1.414213446e-03f, 6.227724371e-04f, 2.742481884e-04f, 1.207697424e-04f, 5.318296462e-05f, 2.341999789e-05f, 1.031338525e-05f, 4.541670478e-06f};

__device__ __forceinline__ float wave_sum(float v) {
#pragma unroll
    for (int o = 1; o < 64; o <<= 1) v += __shfl_xor(v, o);
    return v;
}
__device__ __forceinline__ void unpack8(const u32x4 w, float* v) { v[0] = bf_lo(w.x); v[1] = bf_hi(w.x); v[2] = bf_lo(w.y); v[3] = bf_hi(w.y); v[4] = bf_lo(w.z); v[5] = bf_hi(w.z); v[6] = bf_lo(w.w); v[7] = bf_hi(w.w); }
__device__ __forceinline__ u32x4 pack8(const float* v) { u32x4 w; w.x = cvt_pk_bf16(v[0], v[1]); w.y = cvt_pk_bf16(v[2], v[3]); w.z = cvt_pk_bf16(v[4], v[5]); w.w = cvt_pk_bf16(v[6], v[7]); return w; }

__device__ __forceinline__ void cvt_item(const float* W, int K, int Nsrc, int Ndst, int mode, const float* gain, bf16_t* dst, LAS float* scr, int it, int lane) {
    const int nblk = Ndst / 32;
    const int kb = it / nblk, nb = it % nblk, k0 = 64 * kb, n0 = 32 * nb;
    int src0;
    if (mode == 1) { const int tile = nb >> 3, w = nb & 7; src0 = (w >> 2) * FFH + tile * 128 + (w & 3) * 32; }
    else src0 = (n0 < Nsrc) ? n0 : -1;
#pragma unroll 8
    for (int i = 0; i < 32; ++i) { const int kk = 2 * i + (lane >> 5); float v = src0 >= 0 ? W[(size_t)(k0 + kk) * Nsrc + src0 + (lane & 31)] : 0.f; if (gain) v *= gain[k0 + kk]; scr[kk * 33 + (lane & 31)] = v; }
    asm volatile("s_waitcnt lgkmcnt(0)" ::: "memory");
    const int c = lane & 7;
#pragma unroll
    for (int j = 0; j < 4; ++j) { const int n = (lane >> 3) + 8 * j; const LAS float* s = scr + (8 * c) * 33 + n;
        u32x4 o; o.x = cvt_pk_bf16(s[0 * 33], s[1 * 33]); o.y = cvt_pk_bf16(s[2 * 33], s[3 * 33]); o.z = cvt_pk_bf16(s[4 * 33], s[5 * 33]); o.w = cvt_pk_bf16(s[6 * 33], s[7 * 33]);
        *(u32x4*)(dst + (size_t)(n0 + n) * K + k0 + 8 * c) = o; }
    asm volatile("s_waitcnt lgkmcnt(0)" ::: "memory");
}
struct Args { const float* in[24]; float* out; unsigned char* ws; int ph_lo, ph_hi; };
__device__ __forceinline__ void cvt_layer(const Args& a, int L, bf16_t* WLp, LAS float* scr, int gw, int NGW, int part  ) {
    int tl = threadIdx.x; asm volatile("" : "+v"(tl)); const int lane = tl & 63;
    const int j = L >> 1; const bool isA = (L & 1) == 0;
    const int n0 = isA ? 768 : 384, n1 = isA ? 512 : 288, n2 = isA ? 0 : 128, n3 = isA ? 0 : 512;
    const int total = n0 + n1 + n2 + n3 + 2816 + 1408 + 512 + 128;
    const int nm = n0 + n1 + n2 + n3; const int it_lo = (part & 1) ? 0 : ((part & 2) ? nm : nm + 4224), it_hi = (part & 4) ? total : ((part & 2) ? nm + 4224 : nm);
    for (int it = it_lo + gw; it < it_hi; it += NGW) {
        int r = it; const float* W; int K, Nsrc, Ndst, mode = 0; const float* gain = nullptr; size_t doff;
        if (r < n0) { if (isA) { W = a.in[5] + (size_t)j * 1024 * 1536; K = 1024; Nsrc = 1536; Ndst = 1536; } else { W = a.in[10] + (size_t)j * 1024 * 544; K = 1024; Nsrc = 544; Ndst = 768; } gain = a.in[4] + L * 1024; doff = WO_MIX; }
        else if ((r -= n0) < n1) { if (isA) { W = a.in[9] + (size_t)j * 1024 * 1024; K = 1024; Nsrc = 1024; Ndst = 1024; doff = WO_MIX_O_A; } else { W = a.in[13] + (size_t)j * 384 * 1536; K = 384; Nsrc = 1536; Ndst = 1536; gain = a.in[11] + j * 384; doff = WO_B_UQ; } }
        else if ((r -= n1) < n2) { W = a.in[14] + (size_t)j * 128 * 2048; K = 128; Nsrc = 2048; Ndst = 2048; gain = a.in[12] + j * 128; doff = WO_B_UKV; }
        else if ((r -= n2) < n3) { W = a.in[17] + (size_t)j * 1024 * 1024; K = 1024; Nsrc = 1024; Ndst = 1024; doff = WO_B_O; }
        else if ((r -= n3) < 2816) { W = a.in[19] + (size_t)L * 1024 * 5632; K = 1024; Nsrc = 5632; Ndst = 5632; mode = 1; gain = a.in[18] + L * 1024; doff = WO_GU; }
        else if ((r -= 2816) < 1408) { W = a.in[20] + (size_t)L * 2816 * 1024; K = 2816; Nsrc = 1024; Ndst = 1024; doff = WO_D; }
        else if ((r -= 1408) < 512) { W = a.in[22] + (size_t)L * 1024 * 1024; K = 1024; Nsrc = 1024; Ndst = 1024; gain = a.in[21] + L * 1024; doff = WO_PG; }
        else { r -= 512; W = a.in[23] + (size_t)L * 256 * 1024; K = 256; Nsrc = 1024; Ndst = 1024; doff = WO_PP; }
        cvt_item(W, K, Nsrc, Ndst, mode, gain, WLp + doff, scr, r, lane);
    }
}

__device__ __forceinline__ int crow(int r, int hi) { return (r & 3) + 8 * (r >> 2) + 4 * hi; }
typedef float f32x2_t __attribute__((ext_vector_type(2))); typedef __bf16 bf16x2_t __attribute__((ext_vector_type(2)));
__device__ __forceinline__ float max3f(float a, float b, float c) { float r; asm("v_max3_f32 %0, %1, %2, %3" : "=v"(r) : "v"(a), "v"(b), "v"(c)); return r; }
__device__ __forceinline__ unsigned cvtpk_s(float lo, float hi) { f32x2_t v = {lo, hi}; bf16x2_t b = __builtin_convertvector(v, bf16x2_t); return __builtin_bit_cast(unsigned, b); }
template <int DQK, bool WIN>
__device__ __forceinline__ void attn_unit(LAS unsigned char* lds, const bf16_t* qrow, bf16_t* orow, const bf16_t* Kb, int ldk, const bf16_t* Vtb, int ldv,
                                          int kt0, int kt1, int qpos, float m_init, float l_init, const float* qg = nullptr, const f32x2* rope = nullptr) {
    constexpr int KP = DQK + 8, VP = 72, KBUF = 64 * KP * 2, VBUF = 64 * VP * 2, CPR = DQK / 8, NCH = 64 * CPR, ND = DQK / 16;
    constexpr float THR = 8.f;
    int tid_l = threadIdx.x; asm volatile("" : "+v"(tid_l));
    const int tid = tid_l, lane = tid & 63, r32 = lane & 31, hi = lane >> 5;
    LAS unsigned char* Kl = lds; LAS unsigned char* Vl = lds + 2 * KBUF;
    bf16x8 qf[ND];
#pragma unroll
    for (int d0 = 0; d0 < ND; ++d0) qf[d0] = *(const bf16x8*)(qrow + d0 * 16 + hi * 8);
    if (!WIN && qg) {
        float a[ND][8]; float ss = 0.f;
#pragma unroll
        for (int d0 = 0; d0 < ND; ++d0) { unpack8(__builtin_bit_cast(u32x4, qf[d0]), a[d0]);
#pragma unroll
            for (int e = 0; e < 8; ++e) ss += a[d0][e] * a[d0][e]; }
        ss += __shfl_xor(ss, 32);
        const float rs = __builtin_amdgcn_rsqf(ss * (1.f / 96.f) + EPS), qs = 0.10206207261596575f * LOG2E;
#pragma unroll
        for (int d0 = 0; d0 < ND; ++d0) { const f32x4 g0 = *(const f32x4*)(qg + d0 * 16 + hi * 8), g1 = *(const f32x4*)(qg + d0 * 16 + hi * 8 + 4);
#pragma unroll
            for (int e = 0; e < 4; ++e) { a[d0][e] *= rs * g0[e]; a[d0][4 + e] *= rs * g1[e]; } }
#pragma unroll
        for (int e = 0; e < 8; ++e) { const f32x2 cs = rope[qpos * 16 + 8 * hi + e]; const float x1 = a[4][e], x2 = a[5][e]; a[4][e] = x1 * cs.x - x2 * cs.y; a[5][e] = x1 * cs.y + x2 * cs.x; }
#pragma unroll
        for (int d0 = 0; d0 < ND; ++d0) {
#pragma unroll
            for (int e = 0; e < 8; ++e) a[d0][e] *= qs;
            qf[d0] = __builtin_bit_cast(bf16x8, pack8(a[d0])); }
    }
    f32x16 o0, o1, negm;
#pragma unroll
    for (int r = 0; r < 16; ++r) { o0[r] = 0.f; o1[r] = 0.f; negm[r] = -m_init; }
    float m = m_init, l = hi == 0 ? l_init : 0.f;
    u32x4 kxa0, kxa1, vxa, kxb0, kxb1, vxb;
    const int c1 = (tid + 512) < NCH ? tid + 512 : tid;
    const int kr0 = tid / CPR, kc0 = tid % CPR, kr1 = c1 / CPR, kc1 = c1 % CPR;
    const int vd = tid >> 3, vcc = tid & 7;
    const int n = kt1 - kt0;
#define ATT_LOADK(K0_, K1_, t) do { K0_ = *(const u32x4*)(Kb + (size_t)(64 * (t) + kr0) * ldk + kc0 * 8); if (NCH > 512) K1_ = *(const u32x4*)(Kb + (size_t)(64 * (t) + kr1) * ldk + kc1 * 8); } while (0)
#define ATT_LOADV(V_, t) do { V_ = *(const u32x4*)(Vtb + (size_t)vd * ldv + 64 * (t) + vcc * 8); } while (0)
#define ATT_STOREK(K0_, K1_, b) do { *(LAS u32x4*)(Kl + (b) * KBUF + kr0 * (KP * 2) + kc0 * 16) = K0_; if (NCH > 512) *(LAS u32x4*)(Kl + (b) * KBUF + kr1 * (KP * 2) + kc1 * 16) = K1_; } while (0)
#define ATT_STOREV(V_, b) do { *(LAS u32x4*)(Vl + (b) * VBUF + vd * (VP * 2) + vcc * 16) = V_; } while (0)
#define ATT_BAR() do { asm volatile("s_waitcnt lgkmcnt(0)" ::: "memory"); __builtin_amdgcn_s_barrier(); asm volatile("" ::: "memory"); } while (0)
#define ATT_QK(S0, S1, b) do { const LAS unsigned char* kp_ = Kl + (b) * KBUF + r32 * (KP * 2) + hi * 16; \
        _Pragma("unroll") for (int d0 = 0; d0 < ND; ++d0) { const bf16x8 k0_ = *(const LAS bf16x8*)(kp_ + d0 * 32); const bf16x8 k1_ = *(const LAS bf16x8*)(kp_ + 32 * KP * 2 + d0 * 32); \
            if (d0 == 0) { S0 = __builtin_amdgcn_mfma_f32_32x32x16_bf16(k0_, qf[0], negm, 0, 0, 0); S1 = __builtin_amdgcn_mfma_f32_32x32x16_bf16(k1_, qf[0], negm, 0, 0, 0); } \
            else { S0 = __builtin_amdgcn_mfma_f32_32x32x16_bf16(k0_, qf[d0], S0, 0, 0, 0); S1 = __builtin_amdgcn_mfma_f32_32x32x16_bf16(k1_, qf[d0], S1, 0, 0, 0); } } } while (0)
#define SB_() __builtin_amdgcn_sched_barrier(0)
#define ATT_MAXP(S0, S1, MXV) do { float mx2_ = __builtin_fmaxf(S0[0], S1[0]); \
        _Pragma("unroll") for (int r = 1; r < 16; ++r) mx2_ = __builtin_fmaxf(mx2_, __builtin_fmaxf(S0[r], S1[r])); MXV = mx2_; } while (0)
#define ATT_EXP(idx_, C0, C1) do { if ((idx_) < 16) { C0[(idx_) & 15] = __builtin_amdgcn_exp2f(C0[(idx_) & 15]); ls_ += C0[(idx_) & 15]; } else { C1[(idx_) & 15] = __builtin_amdgcn_exp2f(C1[(idx_) & 15]); ls_ += C1[(idx_) & 15]; } } while (0)
#define ATT_STEP(i_, C0, C1, N0, N1, LK0, LK1, LV, SK0, SK1, SV) do { const int ii_ = (i_); const int b_ = ii_ & 1; constexpr int NG_ = 2 * ND, EQ_ = 24 / NG_; \
        { const int tk_ = (kt0 + ii_ + 3) < kt1 ? (kt0 + ii_ + 3) : (kt1 - 1), tv_ = (kt0 + ii_ + 2) < kt1 ? (kt0 + ii_ + 2) : (kt1 - 1); ATT_LOADK(LK0, LK1, tk_); ATT_LOADV(LV, tv_); } \
        bf16x8 kf_[NG_]; \
        { const LAS unsigned char* kp_ = Kl + (b_ ^ 1) * KBUF + r32 * (KP * 2) + hi * 16; \
          _Pragma("unroll") for (int g = 0; g < ND; ++g) kf_[g] = *(const LAS bf16x8*)(kp_ + (g & 1) * (32 * KP * 2) + (g >> 1) * 32); } \
        SB_(); \
        if (WIN) { const int kb_ = 64 * (kt0 + ii_) + 4 * hi - qpos; \
            _Pragma("unroll") for (int r = 0; r < 16; ++r) { const int dk_ = kb_ + (r & 3) + 8 * (r >> 2); if (dk_ > 128 || dk_ < -128) C0[r] = -1e30f; if (dk_ + 32 > 128 || dk_ + 32 < -128) C1[r] = -1e30f; } \
            ATT_MAXP(C0, C1, mxc); } \
        float mx_; { auto rr_ = __builtin_amdgcn_permlane32_swap(__float_as_uint(mxc), __float_as_uint(mxc), false, false); mx_ = fmaxf(__uint_as_float(rr_[0]), __uint_as_float(rr_[1])); } \
        const bool first_ = !WIN && ii_ == 0; \
        if (first_ || __any(mx_ > THR)) { const float d_ = first_ ? mx_ : fmaxf(mx_, 0.f); m += d_; const float al_ = __builtin_amdgcn_exp2f(-d_); l *= al_; \
            _Pragma("unroll") for (int r = 0; r < 16; ++r) { C0[r] -= d_; C1[r] -= d_; o0[r] *= al_; o1[r] *= al_; negm[r] = -m; } } \
        SB_(); \
        float ls_ = 0.f; bf16x8 vf_[8]; \
        const LAS unsigned char* vp_ = Vl + b_ * VBUF + r32 * (VP * 2) + hi * 16; \
        _Pragma("unroll") for (int g = 0; g < NG_; ++g) { \
            if ((g & 1) == 0) { if (g == 0) N0 = __builtin_amdgcn_mfma_f32_32x32x16_bf16(kf_[0], qf[0], negm, 0, 0, 0); else N0 = __builtin_amdgcn_mfma_f32_32x32x16_bf16(kf_[g], qf[g >> 1], N0, 0, 0, 0); } \
            else { if (g == 1) N1 = __builtin_amdgcn_mfma_f32_32x32x16_bf16(kf_[1], qf[0], negm, 0, 0, 0); else N1 = __builtin_amdgcn_mfma_f32_32x32x16_bf16(kf_[g], qf[g >> 1], N1, 0, 0, 0); } \
            if (g < ND) { const LAS unsigned char* kp_ = Kl + (b_ ^ 1) * KBUF + r32 * (KP * 2) + hi * 16; kf_[g + ND] = *(const LAS bf16x8*)(kp_ + ((g + ND) & 1) * (32 * KP * 2) + ((g + ND) >> 1) * 32); } \
            if (g >= NG_ - 4) { const int f = g - (NG_ - 4); vf_[f] = *(const LAS bf16x8*)(vp_ + (f & 1) * (32 * VP * 2) + (f >> 1) * 32); } \
            _Pragma("unroll") for (int e = 0; e < EQ_; ++e) ATT_EXP(g * EQ_ + e, C0, C1); \
            SB_(); } \
        u32x4 pw_[4]; \
        pw_[0].x = cvtpk_s(C0[0], C0[1]); pw_[0].y = cvtpk_s(C0[2], C0[3]); pw_[0].z = cvtpk_s(C0[4], C0[5]); pw_[0].w = cvtpk_s(C0[6], C0[7]); \
        SB_(); \
        float mxa_ = 0.f, mxb_ = 0.f; \
        o0 = __builtin_amdgcn_mfma_f32_32x32x16_bf16(vf_[0], __builtin_bit_cast(bf16x8, pw_[0]), o0, 0, 0, 0); \
        pw_[1].x = cvtpk_s(C0[8], C0[9]); pw_[1].y = cvtpk_s(C0[10], C0[11]); ATT_EXP(24, C0, C1); ATT_EXP(25, C0, C1); \
        vf_[4] = *(const LAS bf16x8*)(vp_ + 64); vf_[5] = *(const LAS bf16x8*)(vp_ + (32 * VP * 2) + 64); \
        SB_(); \
        o1 = __builtin_amdgcn_mfma_f32_32x32x16_bf16(vf_[1], __builtin_bit_cast(bf16x8, pw_[0]), o1, 0, 0, 0); \
        pw_[1].z = cvtpk_s(C0[12], C0[13]); pw_[1].w = cvtpk_s(C0[14], C0[15]); ATT_EXP(26, C0, C1); ATT_EXP(27, C0, C1); \
        vf_[6] = *(const LAS bf16x8*)(vp_ + 96); vf_[7] = *(const LAS bf16x8*)(vp_ + (32 * VP * 2) + 96); \
        SB_(); \
        o0 = __builtin_amdgcn_mfma_f32_32x32x16_bf16(vf_[2], __builtin_bit_cast(bf16x8, pw_[1]), o0, 0, 0, 0); \
        pw_[2].x = cvtpk_s(C1[0], C1[1]); pw_[2].y = cvtpk_s(C1[2], C1[3]); ATT_EXP(28, C0, C1); ATT_EXP(29, C0, C1); \
        SB_(); \
        o1 = __builtin_amdgcn_mfma_f32_32x32x16_bf16(vf_[3], __builtin_bit_cast(bf16x8, pw_[1]), o1, 0, 0, 0); \
        pw_[2].z = cvtpk_s(C1[4], C1[5]); pw_[2].w = cvtpk_s(C1[6], C1[7]); ATT_EXP(30, C0, C1); ATT_EXP(31, C0, C1); \
        SB_(); \
        o0 = __builtin_amdgcn_mfma_f32_32x32x16_bf16(vf_[4], __builtin_bit_cast(bf16x8, pw_[2]), o0, 0, 0, 0); \
        pw_[3].x = cvtpk_s(C1[8], C1[9]); pw_[3].y = cvtpk_s(C1[10], C1[11]); \
        if (!WIN) { mxa_ = max3f(N0[0], N1[0], N0[1]); mxb_ = max3f(N1[1], N0[2], N1[2]); mxa_ = max3f(mxa_, N0[3], N1[3]); mxb_ = max3f(mxb_, N0[4], N1[4]); } \
        SB_(); \
        o1 = __builtin_amdgcn_mfma_f32_32x32x16_bf16(vf_[5], __builtin_bit_cast(bf16x8, pw_[2]), o1, 0, 0, 0); \
        pw_[3].z = cvtpk_s(C1[12], C1[13]); pw_[3].w = cvtpk_s(C1[14], C1[15]); \
        if (!WIN) { mxa_ = max3f(mxa_, N0[5], N1[5]); mxb_ = max3f(mxb_, N0[6], N1[6]); mxa_ = max3f(mxa_, N0[7], N1[7]); mxb_ = max3f(mxb_, N0[8], N1[8]); } \
        SB_(); \
        o0 = __builtin_amdgcn_mfma_f32_32x32x16_bf16(vf_[6], __builtin_bit_cast(bf16x8, pw_[3]), o0, 0, 0, 0); \
        if (!WIN) { mxa_ = max3f(mxa_, N0[9], N1[9]); mxb_ = max3f(mxb_, N0[10], N1[10]); mxa_ = max3f(mxa_, N0[11], N1[11]); mxb_ = max3f(mxb_, N0[12], N1[12]); } \
        SB_(); \
        o1 = __builtin_amdgcn_mfma_f32_32x32x16_bf16(vf_[7], __builtin_bit_cast(bf16x8, pw_[3]), o1, 0, 0, 0); \
        if (!WIN) { mxa_ = max3f(mxa_, N0[13], N1[13]); mxb_ = max3f(mxb_, N0[14], N1[14]); mxa_ = max3f(mxa_, N0[15], N1[15]); mxc = fmaxf(mxa_, mxb_); } \
        l += ls_; \
        SB_(); \
        ATT_STOREV(SV, b_ ^ 1); ATT_STOREK(SK0, SK1, b_); \
        ATT_BAR(); } while (0)
    {
        u32x4 kt0_ = {0u, 0u, 0u, 0u}, kt1r_ = {0u, 0u, 0u, 0u};
        const int t1_ = (kt0 + 1) < kt1 ? (kt0 + 1) : (kt1 - 1), t2_ = (kt0 + 2) < kt1 ? (kt0 + 2) : (kt1 - 1);
        ATT_LOADK(kxa0, kxa1, kt0); ATT_LOADV(vxa, kt0); ATT_LOADK(kt0_, kt1r_, t1_); ATT_LOADK(kxb0, kxb1, t2_); ATT_LOADV(vxb, t1_);
        ATT_STOREK(kxa0, kxa1, 0); ATT_STOREV(vxa, 0); ATT_STOREK(kt0_, kt1r_, 1);
    }
    ATT_BAR();
    f32x16 sa0, sa1, sb0, sb1; float mxc = 0.f;
    ATT_QK(sa0, sa1, 0);
    if (!WIN) ATT_MAXP(sa0, sa1, mxc);
    ATT_BAR();
    if (tid >= 256) __builtin_amdgcn_s_setprio(1);
    int it = 0;
    for (; it + 1 < n; it += 2) { ATT_STEP(it, sa0, sa1, sb0, sb1, kxa0, kxa1, vxa, kxb0, kxb1, vxb); ATT_STEP(it + 1, sb0, sb1, sa0, sa1, kxb0, kxb1, vxb, kxa0, kxa1, vxa); }
    if (it < n) ATT_STEP(it, sa0, sa1, sb0, sb1, kxa0, kxa1, vxa, kxb0, kxb1, vxb);
    __builtin_amdgcn_s_setprio(0);
    asm volatile("s_waitcnt vmcnt(0)" ::: "memory");
#undef ATT_LOADK
#undef ATT_LOADV
#undef ATT_STOREK
#undef ATT_STOREV
#undef ATT_QK
#undef ATT_STEP
#undef ATT_MAXP
#undef ATT_EXP
#undef SB_
#undef ATT_BAR
    l += __shfl_xor(l, 32); const float rl = 1.f / l;
#pragma unroll
    for (int g = 0; g < 4; ++g) { u32x2 w; w.x = cvt_pk_bf16(o0[4 * g] * rl, o0[4 * g + 1] * rl); w.y = cvt_pk_bf16(o0[4 * g + 2] * rl, o0[4 * g + 3] * rl); *(u32x2*)(orow + 8 * g + 4 * hi) = w;
        w.x = cvt_pk_bf16(o1[4 * g] * rl, o1[4 * g + 1] * rl); w.y = cvt_pk_bf16(o1[4 * g + 2] * rl, o1[4 * g + 3] * rl); *(u32x2*)(orow + 32 + 8 * g + 4 * hi) = w; }
}

__device__ __forceinline__ void win_unit(LAS unsigned char* lds, bf16_t* QKV, const bf16_t* VTA, int st, int S, int nblk, int kvh, const float* sink) {
    constexpr int RP = 144, TB = 64 * RP;
    int tid_l = threadIdx.x; asm volatile("" : "+v"(tid_l));
    const int tid = tid_l, lane = tid & 63, r32 = lane & 31, hi = lane >> 5, wid = __builtin_amdgcn_readfirstlane(tid >> 6);
    const int nt_all = S >> 6, kt0 = (2 * nblk - 2) > 0 ? (2 * nblk - 2) : 0, kt1 = (2 * nblk + 4) < nt_all ? (2 * nblk + 4) : nt_all, nt = kt1 - kt0;
    LAS unsigned char* Kl = lds; LAS unsigned char* Vl = lds + 6 * TB;
    const bf16_t* Kb = QKV + (size_t)st * 1536 + 1024 + kvh * 64; const bf16_t* Vtb = VTA + (size_t)st * 256 + (size_t)kvh * 64 * S;
    { const int kr = tid >> 3, kc = tid & 7; u32x4 kreg[6], vreg[6];
#pragma unroll
      for (int t = 0; t < 6; ++t) if (t < nt) { kreg[t] = *(const u32x4*)(Kb + (size_t)(64 * (kt0 + t) + kr) * 1536 + kc * 8); vreg[t] = *(const u32x4*)(Vtb + (size_t)kr * S + 64 * (kt0 + t) + kc * 8); }
#pragma unroll
      for (int t = 0; t < 6; ++t) if (t < nt) { *(LAS u32x4*)(Kl + t * TB + kr * RP + kc * 16) = kreg[t]; *(LAS u32x4*)(Vl + t * TB + kr * RP + kc * 16) = vreg[t]; } }
    __syncthreads();
    for (int p = 0; p < 2; ++p) {
        const int head = kvh * 4 + 2 * p + (wid >> 2), wq0 = nblk * 128 + (wid & 3) * 32, qpos = wq0 + r32;
        bf16_t* qrow = QKV + (size_t)(st + qpos) * 1536 + head * 64;
        bf16x8 qf[4];
#pragma unroll
        for (int d0 = 0; d0 < 4; ++d0) qf[d0] = *(const bf16x8*)(qrow + d0 * 16 + hi * 8);
        f32x16 o0, o1;
#pragma unroll
        for (int r = 0; r < 16; ++r) { o0[r] = 0.f; o1[r] = 0.f; }
        float m = sink[head] * LOG2E, l = hi == 0 ? 1.f : 0.f;
        for (int t = 0; t < nt; ++t) {
            const int k0pos = 64 * (kt0 + t);
            if (k0pos > wq0 + 159 || k0pos + 63 < wq0 - 128) continue;
            f32x16 s0, s1;
#pragma unroll
            for (int r = 0; r < 16; ++r) { s0[r] = 0.f; s1[r] = 0.f; }
            const LAS unsigned char* kp = Kl + t * TB + r32 * RP + hi * 16;
#pragma unroll
            for (int d0 = 0; d0 < 4; ++d0) { const bf16x8 k0 = *(const LAS bf16x8*)(kp + d0 * 32); const bf16x8 k1 = *(const LAS bf16x8*)(kp + 32 * RP + d0 * 32);
                s0 = __builtin_amdgcn_mfma_f32_32x32x16_bf16(k0, qf[d0], s0, 0, 0, 0); s1 = __builtin_amdgcn_mfma_f32_32x32x16_bf16(k1, qf[d0], s1, 0, 0, 0); }
            { const int kb = k0pos + 4 * hi - qpos;
#pragma unroll
              for (int r = 0; r < 16; ++r) { const int dk = kb + (r & 3) + 8 * (r >> 2); if (dk > 128 || dk < -128) s0[r] = -1e30f; if (dk + 32 > 128 || dk + 32 < -128) s1[r] = -1e30f; } }
            float mx = __builtin_fmaxf(s0[0], s1[0]);
#pragma unroll
            for (int r = 1; r < 16; ++r) mx = __builtin_fmaxf(mx, __builtin_fmaxf(s0[r], s1[r]));
            mx = __builtin_fmaxf(mx, __shfl_xor(mx, 32));
            const float mn = __builtin_fmaxf(m, mx), alpha = __builtin_amdgcn_exp2f(m - mn); m = mn;
            float ls = 0.f;
#pragma unroll
            for (int r = 0; r < 16; ++r) { s0[r] = __builtin_amdgcn_exp2f(s0[r] - mn); s1[r] = __builtin_amdgcn_exp2f(s1[r] - mn); ls += s0[r] + s1[r]; }
            l = l * alpha + ls;
#pragma unroll
            for (int r = 0; r < 16; ++r) { o0[r] *= alpha; o1[r] *= alpha; }
            u32x4 pw[4];
#pragma unroll
            for (int c = 0; c < 2; ++c) { pw[c].x = cvtpk_s(s0[8 * c], s0[8 * c + 1]); pw[c].y = cvtpk_s(s0[8 * c + 2], s0[8 * c + 3]); pw[c].z = cvtpk_s(s0[8 * c + 4], s0[8 * c + 5]); pw[c].w = cvtpk_s(s0[8 * c + 6], s0[8 * c + 7]);
                pw[2 + c].x = cvtpk_s(s1[8 * c], s1[8 * c + 1]); pw[2 + c].y = cvtpk_s(s1[8 * c + 2], s1[8 * c + 3]); pw[2 + c].z = cvtpk_s(s1[8 * c + 4], s1[8 * c + 5]); pw[2 + c].w = cvtpk_s(s1[8 * c + 6], s1[8 * c + 7]); }
            const LAS unsigned char* vp = Vl + t * TB + r32 * RP + hi * 16;
#pragma unroll
            for (int j = 0; j < 4; ++j) { const bf16x8 v0 = *(const LAS bf16x8*)(vp + j * 32); const bf16x8 v1 = *(const LAS bf16x8*)(vp + 32 * RP + j * 32);
                o0 = __builtin_amdgcn_mfma_f32_32x32x16_bf16(v0, __builtin_bit_cast(bf16x8, pw[j]), o0, 0, 0, 0); o1 = __builtin_amdgcn_mfma_f32_32x32x16_bf16(v1, __builtin_bit_cast(bf16x8, pw[j]), o1, 0, 0, 0); }
        }
        l += __shfl_xor(l, 32); const float rl = 1.f / l;
#pragma unroll
        for (int g = 0; g < 4; ++g) { u32x2 w; w.x = cvt_pk_bf16(o0[4 * g] * rl, o0[4 * g + 1] * rl); w.y = cvt_pk_bf16(o0[4 * g + 2] * rl, o0[4 * g + 3] * rl); *(u32x2*)(qrow + 8 * g + 4 * hi) = w;
            w.x = cvt_pk_bf16(o1[4 * g] * rl, o1[4 * g + 1] * rl); w.y = cvt_pk_bf16(o1[4 * g + 2] * rl, o1[4 * g + 3] * rl); *(u32x2*)(qrow + 32 + 8 * g + 4 * hi) = w; }
    }
    __syncthreads();
}

__device__ __forceinline__ void pb_chunk(const float* pp, const float* ps, int layer, bf16_t* PB, int tok0, int tid) {
    f32x4 v[8];
#pragma unroll
    for (int k = 0; k < 8; ++k) { const int idx4 = tid + 512 * k, tok = tok0 + (idx4 >> 6), c4 = idx4 & 63; const int e = ext_row(tok);
        const float* src = e < 65536 ? pp + ((size_t)layer * 65536 + e) * PLE : ps + ((size_t)layer * 32768 + (e - 65536)) * PLE;
        v[k] = *(const f32x4*)(src + c4 * 4); }
#pragma unroll
    for (int k = 0; k < 8; ++k) { const int idx4 = tid + 512 * k, tok = tok0 + (idx4 >> 6), c4 = idx4 & 63;
        u32x2 w; w.x = cvt_pk_bf16(v[k][0], v[k][1]); w.y = cvt_pk_bf16(v[k][2], v[k][3]); *(u32x2*)(PB + (size_t)tok * PLE + c4 * 4) = w; }
}
__device__ __forceinline__ void fixup_a(LAS unsigned char* lds, bf16_t* QKV, bf16_t* VtA, const float* qg, const float* kg, const f32x2* rope, int vcu, int G,
                                        const float* pp, const float* ps, int layer, bf16_t* PB) {
    int tid_l = threadIdx.x; asm volatile("" : "+v"(tid_l));
    const int tid = tid_l, lane = tid & 63, wid = tid >> 6, sub = lane & 7, hl = lane >> 3;
    LAS bf16_t* vt = (LAS bf16_t*)lds;
    for (int chunk = vcu; chunk < TT / 64; chunk += G) {
        const int tok0 = chunk * 64; int st, S; seq_of(tok0, st, S);
        for (int ib = 0; ib < 2; ++ib) {
            u32x4 rawb[4][3]; f32x2 csb[4][8];
#pragma unroll
            for (int t = 0; t < 4; ++t) { const int tok = tok0 + wid * 8 + ib * 4 + t, pos = tok - st; const bf16_t* rowp = QKV + (size_t)tok * 1536;
#pragma unroll
                for (int rr = 0; rr < 3; ++rr) rawb[t][rr] = *(const u32x4*)(rowp + (rr * 8 + hl) * 64 + sub * 8);
#pragma unroll
                for (int e = 0; e < 8; ++e) csb[t][e] = rope[pos * 16 + 2 * e]; }
#pragma unroll
            for (int t = 0; t < 4; ++t) { const int i = ib * 4 + t; const int tok = tok0 + wid * 8 + i; bf16_t* rowp = QKV + (size_t)tok * 1536;
#pragma unroll
                for (int rr = 0; rr < 3; ++rr) { const int hh = rr * 8 + hl; const u32x4 raw = rawb[t][rr];
                    float v[8]; unpack8(raw, v);
                    float ss = 0.f;
#pragma unroll
                    for (int e = 0; e < 8; ++e) ss += v[e] * v[e];
                    ss += __shfl_xor(ss, 1); ss += __shfl_xor(ss, 2); ss += __shfl_xor(ss, 4);
                    const float rs = __builtin_amdgcn_rsqf(ss * (1.f / 64.f) + EPS);
                    const float* g = hh < 16 ? qg : kg;
                    float pv[8];
#pragma unroll
                    for (int e = 0; e < 8; ++e) { v[e] = v[e] * rs * g[sub * 8 + e]; pv[e] = __shfl_xor(v[e], 1); }
                    if (sub < 2) {
#pragma unroll
                        for (int e = 0; e < 8; ++e) { const f32x2 cs = csb[t][e]; v[e] = sub == 0 ? v[e] * cs.x - pv[e] * cs.y : pv[e] * cs.y + v[e] * cs.x; } }
                    if (hh < 16) {
#pragma unroll
                        for (int e = 0; e < 8; ++e) v[e] *= 0.125f * LOG2E; }
                    if (hh < 20) *(u32x4*)(rowp + hh * 64 + sub * 8) = pack8(v);
                    else { const int hv = hh - 20; const unsigned w[4] = {raw.x, raw.y, raw.z, raw.w};
#pragma unroll
                        for (int e = 0; e < 8; ++e) vt[(hv * 64 + sub * 8 + e) * 72 + wid * 8 + i] = (bf16_t)((e & 1) ? (w[e >> 1] >> 16) : (w[e >> 1] & 0xffffu)); } } } }
        __syncthreads();
#pragma unroll
        for (int k = 0; k < 4; ++k) { const int c = tid + 512 * k, row = c >> 3, cc = c & 7, hv = row >> 6, d = row & 63;
            const u32x2 d0_ = *(const LAS u32x2*)(vt + row * 72 + (cc >> 1) * 16 + (cc & 1) * 4), d1_ = *(const LAS u32x2*)(vt + row * 72 + (cc >> 1) * 16 + 8 + (cc & 1) * 4);
            u32x4 dat; dat.x = d0_.x; dat.y = d0_.y; dat.z = d1_.x; dat.w = d1_.y;
            *(u32x4*)(VtA + (size_t)st * 256 + (size_t)hv * 64 * S + (size_t)d * S + (tok0 - st) + cc * 8) = dat; }
        pb_chunk(pp, ps, layer, PB, tok0, tid);
        __syncthreads();
    }
}
__device__ __forceinline__ void fixup_b(LAS unsigned char* lds, const bf16_t* Q, bf16_t* Qo, const bf16_t* KV, const float* KR, bf16_t* K, bf16_t* VtB, const float* qg, const float* kg, const f32x2* rope,
                                        int hf, int vcu, int G) {
    int tid_l = threadIdx.x; asm volatile("" : "+v"(tid_l));
    const int tid = tid_l, lane = tid & 63, wid = tid >> 6, sub = lane & 7, hl = lane >> 3;
    LAS bf16_t* vt = (LAS bf16_t*)lds;
    const float qscale = 0.10206207261596575f * LOG2E;
    for (int chunk = vcu; chunk < TH / 32; chunk += G) {
        const int lt0 = chunk * 32; int st, S; seq_of(hf * TH + lt0, st, S); const int lst = st - hf * TH;
        for (int ib = 0; ib < 2; ++ib) {
            f32x2 csb[2][4]; f32x4 krb[2]; u32x4 qn[2][2], kn[2][2], vn[2][2]; u32x2 qr2[2][2];
#pragma unroll
            for (int t = 0; t < 2; ++t) { const int lt = lt0 + wid * 4 + ib * 2 + t, pos = lt - lst; const int fi = 4 * (sub & 3);
#pragma unroll
                for (int e = 0; e < 4; ++e) csb[t][e] = rope[pos * 16 + fi + e];
                krb[t] = *(const f32x4*)(KR + (size_t)lt * 32 + sub * 4);
#pragma unroll
                for (int rr = 0; rr < 2; ++rr) { const int h = rr * 8 + hl; const bf16_t* qp = Q + (size_t)lt * 1536 + h * 96; const bf16_t* kvp = KV + (size_t)lt * 2048 + h * 128;
                    kn[t][rr] = *(const u32x4*)(kvp + sub * 8); vn[t][rr] = *(const u32x4*)(kvp + 64 + sub * 8); } }
#pragma unroll
            for (int t = 0; t < 2; ++t) { const int i = ib * 2 + t; const int lt = lt0 + wid * 4 + i; const f32x4 krv = krb[t];
#pragma unroll
                for (int rr = 0; rr < 2; ++rr) { const int h = rr * 8 + hl;
                    {
                        const u32x4 rn = kn[t][rr]; const u32x4 rv = vn[t][rr];
                        float a[8]; unpack8(rn, a); float b[4] = {krv[0], krv[1], krv[2], krv[3]};
                        float ss = 0.f;
#pragma unroll
                        for (int e = 0; e < 8; ++e) ss += a[e] * a[e];
#pragma unroll
                        for (int e = 0; e < 4; ++e) ss += b[e] * b[e];
                        ss += __shfl_xor(ss, 1); ss += __shfl_xor(ss, 2); ss += __shfl_xor(ss, 4);
                        const float rs = __builtin_amdgcn_rsqf(ss * (1.f / 96.f) + EPS);
#pragma unroll
                        for (int e = 0; e < 8; ++e) a[e] = a[e] * rs * kg[sub * 8 + e];
#pragma unroll
                        for (int e = 0; e < 4; ++e) { b[e] = b[e] * rs * kg[64 + sub * 4 + e]; const float pb = __shfl_xor(b[e], 4);
                            b[e] = sub < 4 ? b[e] * csb[t][e].x - pb * csb[t][e].y : pb * csb[t][e].y + b[e] * csb[t][e].x; }
                        bf16_t* kp = K + (size_t)lt * 1536 + h * 96;
                        *(u32x4*)(kp + sub * 8) = pack8(a); u32x2 w; w.x = cvt_pk_bf16(b[0], b[1]); w.y = cvt_pk_bf16(b[2], b[3]); *(u32x2*)(kp + 64 + sub * 4) = w;
                        const unsigned wv[4] = {rv.x, rv.y, rv.z, rv.w};
#pragma unroll
                        for (int e = 0; e < 8; ++e) vt[(h * 64 + sub * 8 + e) * 40 + wid * 4 + i] = (bf16_t)((e & 1) ? (wv[e >> 1] >> 16) : (wv[e >> 1] & 0xffffu));
                    } } } }
        __syncthreads();
#pragma unroll
        for (int k = 0; k < 8; ++k) { const int c = tid + 512 * k, row = c >> 2, cc = c & 3, h = row >> 6, d = row & 63;
            const u32x2 d0_ = *(const LAS u32x2*)(vt + row * 40 + (cc >> 1) * 16 + (cc & 1) * 4), d1_ = *(const LAS u32x2*)(vt + row * 40 + (cc >> 1) * 16 + 8 + (cc & 1) * 4);
            u32x4 dat; dat.x = d0_.x; dat.y = d0_.y; dat.z = d1_.x; dat.w = d1_.y;
            *(u32x4*)(VtB + (size_t)lst * 1024 + (size_t)h * 64 * S + (size_t)d * S + (lt0 - lst) + cc * 8) = dat; }
        __syncthreads();
    }
}


__global__ void __launch_bounds__(512, 2) mega(Args a) {
    extern __shared__ __attribute__((aligned(16))) unsigned char lds_raw[];
    LAS unsigned char* lds = (LAS unsigned char*)lds_raw;
    cg::grid_group grid = cg::this_grid();
    const int tid = threadIdx.x, lane = tid & 63, wid = __builtin_amdgcn_readfirstlane(tid >> 6);
    const int G = gridDim.x, bx = blockIdx.x, vcu = (G % 8 == 0) ? (bx % 8) * (G / 8) + bx / 8 : bx;
    const int gw = vcu * 8 + wid, NGW = G * 8;
#define ROPE ((f32x2*)(ws + WS_ROPE))
#define WL ((bf16_t*)(ws + WS_WL))
#define XB ((bf16_t*)(ws + WS_XB))
#define XB2 ((bf16_t*)(ws + WS_XB2))
#define SSV0 ((float*)(ws + WS_SS0))
#define SSV1 ((float*)(ws + WS_SS1))
#define SSL ((float*)(ws + WS_SSL))
#define PB ((bf16_t*)(ws + WS_PB))
#define Hb ((bf16_t*)(ws + WS_H))
#define PROJ ((bf16_t*)(ws + WS_PROJ))
#define QKV ((bf16_t*)(ws + WS_QKV))
#define VTA ((bf16_t*)(ws + WS_VTA))
#define LQ ((bf16_t*)(ws + WS_LQ))
#define LKV ((bf16_t*)(ws + WS_LKV))
#define KR ((float*)(ws + WS_KR))
#define Qh ((bf16_t*)(ws + WS_Q))
#define KVh ((bf16_t*)(ws + WS_KV))
#define Kh ((bf16_t*)(ws + WS_K))
#define VTB ((bf16_t*)(ws + WS_VTB))
#define SSa (s ? SSV1 : SSV0)
#define SSb (s ? SSV0 : SSV1)
    float* X = a.out;
    LAS float* scr = (LAS float*)(lds + wid * 16384);
    if (tid < 2) ((LAS unsigned*)(lds + 131072))[tid] = 0u;
    __syncthreads();
    const XcdBarrier xbar = xcd_barrier_post((unsigned*)(a.ws + WS_BAR), (volatile LAS unsigned*)(lds + 131072));
    int ph = 0; const int lo = a.ph_lo, hi = a.ph_hi;
#define PH_BEGIN if (ph >= lo && ph < hi) { unsigned char* ws = a.ws; asm volatile("" : "+s"(ws));
#define PH_END   if (ph + 1 < hi) { if (ph == 0) grid.sync(); else xcd_barrier(xbar); } } ++ph;
#define CVT_LAYER(L, part) cvt_layer(a, (L), WL, scr, gw, NGW, (part))
#ifndef EN
#define EN 0xffff
#endif
#ifndef DUP
#define DUP 0
#endif
#define REP(bit) for (int rep_ = ((DUP & (bit)) ? 0 : 1); rep_ < 2; ++rep_)
#define AMUL ((float)rep_)
#ifndef STAG_US
#define STAG_US 0
#endif
#define STAGGER(us) do { if (((bx >> 3) & 1) && (us) > 0) { const unsigned long long t0_ = __builtin_amdgcn_s_memrealtime(); while (__builtin_amdgcn_s_memrealtime() - t0_ < (unsigned long long)(us) * 100ull) __builtin_amdgcn_s_sleep(32); } } while (0)
#define GEMM(EpiT, g, E) do { pg8::StaticOrder S_; S_.init((g).M, (g).N, G, bx); pg8::gemm_phase<EpiT, pg8::StaticOrder, true, true>(lds, (g), S_, (E)); } while (0)

    PH_BEGIN

#if EN & 4096
        for (int idx = (vcu * 512 + tid); idx < 8192 * 16; idx += G * 512) { const int pos = idx >> 4, i = idx & 15; const float ang = (float)pos * INV_FREQ[i];
            double rev = (double)ang * 0.15915494309189535; rev -= __builtin_rint(rev); const float rf = (float)rev;
            f32x2 cs; cs.x = __builtin_amdgcn_cosf(rf); cs.y = __builtin_amdgcn_sinf(rf); ROPE[idx] = cs; }
        REP(4096) for (int row0 = gw * 4; row0 < TT; row0 += NGW * 4) {
            f32x4 v[4][4];
#pragma unroll
            for (int t = 0; t < 4; ++t) { const int e = ext_row(row0 + t); const float* src = e < 65536 ? a.in[0] + (size_t)e * DM : a.in[1] + (size_t)(e - 65536) * DM;
#pragma unroll
                for (int j = 0; j < 4; ++j) v[t][j] = *(const f32x4*)(src + (64 * j + lane) * 4); }
#pragma unroll
            for (int t = 0; t < 4; ++t) { const int row = row0 + t, e = ext_row(row); float s = 0.f;
#pragma unroll
                for (int j = 0; j < 4; ++j) s += (v[t][j][0] * v[t][j][0] + v[t][j][1] * v[t][j][1]) + (v[t][j][2] * v[t][j][2] + v[t][j][3] * v[t][j][3]);
                s = wave_sum(s);
#pragma unroll
                for (int j = 0; j < 4; ++j) { *(f32x4*)(X + (size_t)e * DM + (64 * j + lane) * 4) = v[t][j]; u32x2 w; w.x = cvt_pk_bf16(v[t][j][0], v[t][j][1]); w.y = cvt_pk_bf16(v[t][j][2], v[t][j][3]);
                    *(u32x2*)(XB2 + (size_t)row * DM + (64 * j + lane) * 4) = w; }
                if (lane < 16) SSV0[(size_t)row * 16 + lane] = lane == 0 ? s : 0.f; } }
        CVT_LAYER(0, 7);
#endif

    PH_END

#pragma nounroll
    for (int layer = 0; layer < 4; ++layer) {
        const int j = layer >> 1, s = layer & 1;
        if ((layer & 1) == 0) {
            PH_BEGIN
#if EN & 1
REP(1) { pg8::Gemm g{XB2, WL + WO_MIX, TT, 1536, 1024, 1024, 1024}; pg8::EpiScale E{QKV, 1536, pg8::RowScale{SSa, 0, 4, 1.f / 1024.f}}; GEMM(pg8::EpiScale, g, E); }
#endif
 if (layer > 0) CVT_LAYER(layer, 4); PH_END
            PH_BEGIN
#if EN & 2
fixup_a(lds, QKV, VTA, a.in[6] + j * 64, a.in[7] + j * 64, ROPE, vcu, G, a.in[2], a.in[3], layer, PB);
#endif
 PH_END
            PH_BEGIN

#if EN & 4
                for (int u = vcu; u < 3072; u += G) { const int blk = u % 768, kvh = u / 768; const int tok0 = blk * 128; int st, S; seq_of(tok0, st, S);
                    win_unit(lds, QKV, VTA, st, S, (tok0 - st) >> 7, kvh, a.in[8] + j * 16); }
#endif

            PH_END
            PH_BEGIN
#if EN & 8
STAGGER(STAG_US); REP(8) { pg8::Gemm g{QKV, WL + WO_MIX_O_A, TT, 1024, 1024, 1536, 1024}; pg8::EpiResid<false> E{X, 0, XB, SSb, nullptr, pg8::RowScale{nullptr, 0, 0, 0.f}, AMUL, true}; GEMM(pg8::EpiResid<false>, g, E); }
#endif
 PH_END
        } else {
            PH_BEGIN
#if EN & 16
REP(16) { pg8::Gemm g{XB2, WL + WO_MIX, TT, 768, 1024, 1024, 1024}; pg8::EpiLat E{LQ, LKV, KR, SSL, pg8::RowScale{SSa, 0, 4, 1.f / 1024.f}}; GEMM(pg8::EpiLat, g, E); }
#endif
 CVT_LAYER(layer, 4); PH_END
#pragma nounroll
            for (int hf = 0; hf < 2; ++hf) {
                PH_BEGIN

#if EN & 32
                    REP(32) { pg8::Gemm g{LQ + (size_t)hf * TH * 384, WL + WO_B_UQ, TH, 1536, 384, 384, 384}; pg8::EpiScaleT<true> E{Qh, 1536, pg8::RowScale{SSL + (size_t)hf * TH * 16, 0, 2, 1.f / 384.f}}; GEMM(pg8::EpiScaleT<true>, g, E); }
                    REP(32) { pg8::Gemm g{LKV + (size_t)hf * TH * 128, WL + WO_B_UKV, TH, 2048, 128, 128, 128}; pg8::EpiScale E{KVh, 2048, pg8::RowScale{SSL + (size_t)hf * TH * 16, 8, 1, 1.f / 128.f}}; GEMM(pg8::EpiScale, g, E); }
#endif

                PH_END
                PH_BEGIN

#if EN & 64
                    REP(64) fixup_b(lds, Qh, rep_ ? Qh : Kh, KVh, KR + (size_t)hf * TH * 32, Kh, VTB, a.in[15] + j * 96, a.in[16] + j * 96, ROPE, hf, vcu, G);
                    if (hf == 0) { int tp_ = threadIdx.x; asm volatile("" : "+v"(tp_)); for (int chunk = vcu; chunk < TT / 64; chunk += G) pb_chunk(a.in[2], a.in[3], layer, PB, chunk * 64, tp_); }
#endif

                PH_END
                PH_BEGIN

#if EN & 128
                    int tl_ = threadIdx.x; asm volatile("" : "+v"(tl_)); const int lane = tl_ & 63, wid = __builtin_amdgcn_readfirstlane(tl_ >> 6);
                    REP(128)
                    for (int u = vcu; u < 3072; u += G) { int sq0, S, h, qb;
                        if (u < 2048) { const int pair = u >> 5; qb = u & 31; S = 8192; sq0 = (pair >> 4) * 8192; h = pair & 15; }
                        else { const int v = u - 2048, pair = v >> 3; qb = v & 7; S = 2048; sq0 = 32768 + (pair >> 4) * 2048; h = pair & 15; }
                        const size_t qr = (size_t)(sq0 + qb * 256 + wid * 32 + (lane & 31));
                        attn_unit<96, false>(lds, Qh + qr * 1536 + h * 96, KVh + qr * 1024 + h * 64, Kh + (size_t)sq0 * 1536 + h * 96, 1536, VTB + (size_t)sq0 * 1024 + (size_t)h * 64 * S, S, 0, S >> 6, qb * 256 + wid * 32 + (lane & 31), 0.f, 0.f, a.in[15] + j * 96, ROPE); }
#endif

                PH_END
                PH_BEGIN
#if EN & 256
STAGGER(STAG_US); REP(256) { pg8::Gemm g{KVh, WL + WO_B_O, TH, 1024, 1024, 1024, 1024}; pg8::EpiResid<false> E{X, hf * TH, XB + (size_t)hf * TH * DM, SSb + (size_t)hf * TH * 16, nullptr, pg8::RowScale{nullptr, 0, 0, 0.f}, AMUL, true}; GEMM(pg8::EpiResid<false>, g, E); }
#endif
 PH_END
            }
        }
        PH_BEGIN
#if EN & 512
REP(512) { pg8::Gemm g{XB, WL + WO_GU, TT, 5632, 1024, 1024, 1024}; pg8::EpiSwiglu E{Hb, pg8::RowScale{SSb, 0, 4, 1.f / 1024.f}}; GEMM(pg8::EpiSwiglu, g, E); }
#endif
 if (layer < 3) CVT_LAYER(layer + 1, 1); PH_END
        PH_BEGIN

#if EN & 1024
            STAGGER((STAG_US * 2)); REP(1024) { pg8::Gemm g{Hb, WL + WO_D, TT, 1024, FFH, FFH, FFH}; pg8::EpiResid<false> E{X, 0, XB, SSa, nullptr, pg8::RowScale{nullptr, 0, 0, 0.f}, AMUL, true}; GEMM(pg8::EpiResid<false>, g, E); }
            REP(1024) { pg8::Gemm g{PB, WL + WO_PP, TT, 1024, PLE, PLE, PLE}; pg8::EpiScale E{PROJ, 1024, pg8::RowScale{nullptr, 0, 0, 0.f}}; GEMM(pg8::EpiScale, g, E); }
#endif

        PH_END
        PH_BEGIN
#if EN & 2048
STAGGER(STAG_US); REP(2048) { pg8::Gemm g{XB, WL + WO_PG, TT, 1024, 1024, 1024, 1024}; pg8::EpiResid<true> E{X, 0, XB2, SSb, PROJ, pg8::RowScale{SSa, 0, 4, 1.f / 1024.f}, AMUL, layer < 3}; GEMM(pg8::EpiResid<true>, g, E); }
#endif
 if (layer < 3) CVT_LAYER(layer + 1, 2); PH_END
    }
}

#ifndef N_LAUNCH_MODE
#define N_LAUNCH_MODE 1
#endif
constexpr int NPH = 39;
extern "C" void kernel_launch(void* const* d_in, const int* in_sizes, int n_in, void* d_out, int out_size, void* d_ws, size_t ws_size, hipStream_t stream) {
    static int grid = 0;
    if (grid == 0) {
        if (n_in != 24 || out_size != TT * DM || ws_size < WS_TOTAL) { fprintf(stderr, "kernel_launch: unexpected sizes n_in %d out %d ws %zu (need %zu)\n", n_in, out_size, ws_size, (size_t)WS_TOTAL); grid = -1; return; }
        int dev = 0, cus = 0, per_cu = 0;
        (void)hipGetDevice(&dev); (void)hipDeviceGetAttribute(&cus, hipDeviceAttributeMultiprocessorCount, dev);
        if (hipFuncSetAttribute((const void*)mega, hipFuncAttributeMaxDynamicSharedMemorySize, LDS_BYTES) != hipSuccess) { fprintf(stderr, "kernel_launch: hipFuncSetAttribute failed\n"); grid = -1; return; }
        if (hipOccupancyMaxActiveBlocksPerMultiprocessor(&per_cu, (const void*)mega, 512, LDS_BYTES) != hipSuccess || per_cu < 1) { fprintf(stderr, "kernel_launch: occupancy query %d\n", per_cu); per_cu = 1; }
        (void)hipGetLastError();
        grid = cus * 1;
        if (grid <= 0) grid = 256;
    }
    if (grid < 0) return;
    if (hipMemsetAsync((char*)d_ws + WS_BAR, 0, WS_BAR_BYTES, stream) != hipSuccess) { fprintf(stderr, "kernel_launch: memset failed\n"); return; }
    Args a{};
    for (int i = 0; i < 24; ++i) a.in[i] = (const float*)d_in[i];
    a.out = (float*)d_out; a.ws = (unsigned char*)d_ws;
#if N_LAUNCH_MODE == 1
    a.ph_lo = 0; a.ph_hi = 1 << 20;
    void* args[] = {&a};
    hipError_t e = hipLaunchCooperativeKernel((const void*)mega, dim3(grid), dim3(512), args, LDS_BYTES, stream);
    if (e != hipSuccess) fprintf(stderr, "cooperative launch failed: %s (grid %d)\n", hipGetErrorString(e), grid);
#else
    for (int p = 0; p < NPH; ++p) { a.ph_lo = p; a.ph_hi = p + 1; hipLaunchKernelGGL(mega, dim3(grid), dim3(512), LDS_BYTES, stream, a); }
#endif
}
```
